# Optimizing an MI355X kernel written in HIP

```python
import math
import jax
import jax.numpy as jnp
from jax import lax
import numpy as np

D_MODEL = 1024
BATCH = 8
SEQ = 2048
DEPTH = 2
DEC_BATCH = 32
DEC_SEQ = 1
PAST_LEN = 8192
PAGE_SIZE = 128

N_EVEN = (DEPTH + 1) // 2
N_ODD = DEPTH // 2

A_HEADS = 4
A_DK = 128
A_DV = 128
A_QK = A_HEADS * A_DK
A_WIDTH = A_HEADS * A_DV
A_CONV_CH = 2 * A_QK + A_WIDTH
CONV_W = 4
DELTA_CHUNK = 64

B_HEADS = 8
B_KV = 2
B_HPG = B_HEADS // B_KV
B_DH = 64
B_WIDTH = B_HEADS * B_DH
N_BRANCH = 3
B_KV_COLS = N_BRANCH * 2 * B_KV * B_DH
CMP_BLK = 32
SEL_BLK = 64
SEL_TOPK = 16
WINDOW = 512
SEL_QBLK = 64
WIN_QBLK = 128
B_SCALE = B_DH ** -0.5

EVEN_SIZES = (A_CONV_CH, A_HEADS, A_HEADS, A_WIDTH, B_WIDTH, B_KV_COLS, B_HEADS * N_BRANCH)
EVEN_IN = A_CONV_CH + 2 * A_HEADS + A_WIDTH + B_WIDTH + B_KV_COLS + B_HEADS * N_BRANCH

C_HEADS = 4
C_DK = 128
C_DV = 256
C_QK = C_HEADS * C_DK
C_WIDTH = C_HEADS * C_DV
C_LOWRANK = 16
GLA_TAU = 16.0
GLA_CHUNK = 16
ODD_SIZES = (C_QK, C_QK, C_WIDTH, C_LOWRANK, C_WIDTH)
ODD_IN = 2 * C_QK + 2 * C_WIDTH + C_LOWRANK

D_FF = -(-(8 * D_MODEL) // (3 * 256)) * 256

ALPHA = (2 * DEPTH) ** 0.25
BETA = (8 * DEPTH) ** -0.25
NEG = -1e30
FORCE = 1e9

kernel_name = 'hybrid_deltanet_nsa_gla_deepnorm_step'

f32 = jnp.float32


def split_cols(h, sizes):
    out, s = [], 0
    for n in sizes:
        out.append(h[..., s:s + n])
        s += n
    return out


def layer_norm(x, g, b, eps=1e-5):
    xf = x.astype(f32)
    mu = jnp.mean(xf, -1, keepdims=True)
    var = jnp.mean(jnp.square(xf - mu), -1, keepdims=True)
    return ((xf - mu) * lax.rsqrt(var + eps) * g.astype(f32) + b.astype(f32)).astype(x.dtype)


def rms_norm(x, g, eps=1e-6):
    xf = x.astype(f32)
    return xf * lax.rsqrt(jnp.mean(xf * xf, -1, keepdims=True) + eps) * g.astype(f32)


def l2_normalize(x, eps=1e-6):
    xf = x.astype(f32)
    return xf * lax.rsqrt(jnp.sum(xf * xf, -1, keepdims=True) + eps)


def masked_softmax(s, mask):
    p = jax.nn.softmax(jnp.where(mask, s, NEG), axis=-1)
    return jnp.where(mask, p, 0.0)


def causal_conv(x, buf, w):
    T = x.shape[1]
    xp = jnp.concatenate([buf, x], axis=1)
    y = xp[:, 0:T] * w[0]
    for j in range(1, CONV_W):
        y = y + xp[:, j:j + T] * w[j]
    return y, xp[:, -(CONV_W - 1):]


def to_chunks(a, C, pad):
    a = jnp.pad(a.astype(f32), [(0, 0), (0, pad)] + [(0, 0)] * (a.ndim - 2))
    B_, Tp = a.shape[:2]
    a = a.reshape((B_, Tp // C, C) + a.shape[2:])
    return jnp.moveaxis(a, 3, 1)


def from_chunks(o, T):
    N, B_, H, C, D = o.shape
    return jnp.transpose(o, (1, 0, 3, 2, 4)).reshape(B_, N * C, H, D)[:, :T]


def gated_delta_chunked(q, k, v, g, beta, S0):
    B_, T, H, _ = q.shape
    C = min(DELTA_CHUNK, T)
    pad = (-T) % C
    q, k, v, g, beta = [to_chunks(a, C, pad) for a in (q, k, v, g, beta)]
    q = q * (A_DK ** -0.5)
    gam = jnp.cumsum(g, axis=-1)
    causal = jnp.tril(jnp.ones((C, C), bool))
    strict = jnp.tril(jnp.ones((C, C), bool), -1)
    diff = gam[..., :, None] - gam[..., None, :]
    Ldec = jnp.where(causal, jnp.exp(jnp.where(causal, diff, 0.0)), 0.0)
    kb = k * beta[..., None]
    A = jnp.where(strict, jnp.einsum('bhncd,bhnsd->bhncs', kb, k) * Ldec, 0.0)
    eye = jnp.eye(C, dtype=f32)
    Tm = lax.linalg.triangular_solve(eye + A, jnp.broadcast_to(eye, A.shape), left_side=True, lower=True)
    u = jnp.einsum('bhncs,bhnse->bhnce', Tm, v * beta[..., None])
    w = jnp.einsum('bhncs,bhnsd->bhncd', Tm, kb * jnp.exp(gam)[..., None])
    qk = jnp.einsum('bhncd,bhnsd->bhncs', q, k) * Ldec
    qg = q * jnp.exp(gam)[..., None]
    kdec = k * jnp.exp(gam[..., -1:] - gam)[..., None]
    glast = jnp.exp(gam[..., -1])

    def step(S, xs):
        u_c, w_c, qk_c, qg_c, kd_c, gl_c = xs
        v_new = u_c - jnp.einsum('bhcd,bhde->bhce', w_c, S)
        o = jnp.einsum('bhcd,bhde->bhce', qg_c, S) + jnp.einsum('bhcs,bhse->bhce', qk_c, v_new)
        S = S * gl_c[..., None, None] + jnp.einsum('bhcd,bhce->bhde', kd_c, v_new)
        return S, o

    xs = tuple(jnp.moveaxis(a, 2, 0) for a in (u, w, qk, qg, kdec, glast))
    S, o = lax.scan(step, S0.astype(f32), xs)
    return from_chunks(o, T), S


def gla_chunked(q, k, v, log_a, S0):
    B_, T, H, _ = q.shape
    C = min(GLA_CHUNK, T)
    pad = (-T) % C
    q, k, v, la = [to_chunks(a, C, pad) for a in (q, k, v, log_a)]
    q = q * (C_DK ** -0.5)
    b = jnp.cumsum(la, axis=3)
    qt = q * jnp.exp(b)
    kt = k * jnp.exp(-b)
    causal = jnp.tril(jnp.ones((C, C), bool))
    att = jnp.where(causal, jnp.einsum('bhncd,bhnsd->bhncs', qt, kt), 0.0)
    intra = jnp.einsum('bhncs,bhnse->bhnce', att, v)
    kdec = k * jnp.exp(b[..., -1:, :] - b)
    glast = jnp.exp(b[..., -1, :])

    def step(S, xs):
        qt_c, kd_c, v_c, in_c, gl_c = xs
        o = jnp.einsum('bhcd,bhde->bhce', qt_c, S) + in_c
        S = S * gl_c[..., None] + jnp.einsum('bhcd,bhce->bhde', kd_c, v_c)
        return S, o

    xs = tuple(jnp.moveaxis(a, 2, 0) for a in (qt, kdec, v, intra, glast))
    S, o = lax.scan(step, S0.astype(f32), xs)
    return from_chunks(o, T), S


def nsa_compressed(q, qpos, kc, vc):
    B_, Tq = q.shape[:2]
    Tk = kc.shape[1]
    nc = Tk // CMP_BLK
    kcb = jnp.mean(kc[:, :nc * CMP_BLK].reshape(B_, nc, CMP_BLK, B_KV, B_DH), axis=2)
    vcb = jnp.mean(vc[:, :nc * CMP_BLK].reshape(B_, nc, CMP_BLK, B_KV, B_DH), axis=2)
    qg = q.reshape(B_, Tq, B_KV, B_HPG, B_DH)
    s = jnp.einsum('bqghd,bcgd->bghqc', qg, kcb) * B_SCALE
    mask = (jnp.arange(nc)[None, :] + 1) * CMP_BLK <= qpos[:, None] + 1
    p = masked_softmax(s, mask)
    o = jnp.einsum('bghqc,bcgd->bqghd', p, vcb).reshape(B_, Tq, B_HEADS, B_DH)
    return o, jnp.sum(p, axis=2)


def nsa_select_blocks(imp, qpos, Tk):
    B_, G, Tq, nc = imp.shape
    ns = -(-Tk // SEL_BLK)
    r = SEL_BLK // CMP_BLK
    imp = jnp.pad(imp, ((0, 0), (0, 0), (0, 0), (0, ns * r - nc)))
    imp = jnp.sum(imp.reshape(B_, G, Tq, ns, r), axis=-1)
    blk = jnp.arange(ns)[None, :]
    cur = (qpos // SEL_BLK)[:, None]
    valid = blk * SEL_BLK <= qpos[:, None]
    forced = (blk == 0) | (blk == cur) | (blk == cur - 1)
    score = jnp.where(forced, FORCE, jnp.where(valid, imp, NEG))
    _, idx = lax.top_k(score, min(SEL_TOPK, ns))
    return idx


def nsa_selected(q, qpos, ks, vs, idx):
    B_, Tk = ks.shape[:2]
    Tq = q.shape[1]
    ns = -(-Tk // SEL_BLK)
    padk = ns * SEL_BLK - Tk
    kb = jnp.pad(ks, ((0, 0), (0, padk), (0, 0), (0, 0))).reshape(B_, ns, SEL_BLK, B_KV, B_DH).transpose(0, 3, 1, 2, 4)
    vb = jnp.pad(vs, ((0, 0), (0, padk), (0, 0), (0, 0))).reshape(B_, ns, SEL_BLK, B_KV, B_DH).transpose(0, 3, 1, 2, 4)
    qb = SEL_QBLK if Tq % SEL_QBLK == 0 else Tq
    gather = jax.vmap(jax.vmap(lambda tbl, i: tbl[i]))

    def block(i):
        s0 = i * qb
        qi = lax.dynamic_slice_in_dim(q, s0, qb, 1).reshape(B_, qb, B_KV, B_HPG, B_DH)
        pi = lax.dynamic_slice_in_dim(qpos, s0, qb, 0)
        ii = lax.dynamic_slice_in_dim(idx, s0, qb, 2)
        kg = gather(kb, ii)
        vg = gather(vb, ii)
        nk = ii.shape[-1] * SEL_BLK
        s = jnp.einsum('bqghd,bgqksd->bghqks', qi, kg) * B_SCALE
        s = s.reshape(B_, B_KV, B_HPG, qb, nk)
        kpos = ii[..., None] * SEL_BLK + jnp.arange(SEL_BLK)
        mask = (kpos <= pi[None, None, :, None, None]).reshape(B_, B_KV, 1, qb, nk)
        p = masked_softmax(s, mask)
        o = jnp.einsum('bghqn,bgqnd->bqghd', p, vg.reshape(B_, B_KV, qb, nk, B_DH))
        return o.reshape(B_, qb, B_HEADS, B_DH)

    out = lax.map(block, jnp.arange(Tq // qb))
    return jnp.moveaxis(out, 0, 1).reshape(B_, Tq, B_HEADS, B_DH)


def window_attend(q, qpos, k, v, kpos):
    B_, Q = q.shape[:2]
    qg = q.reshape(B_, Q, B_KV, B_HPG, B_DH)
    s = jnp.einsum('bqghd,bkgd->bghqk', qg, k) * B_SCALE
    d = qpos[:, None] - kpos[None, :]
    mask = (d >= 0) & (d < WINDOW) & (kpos[None, :] >= 0)
    p = masked_softmax(s, mask)
    return jnp.einsum('bghqk,bkgd->bqghd', p, v).reshape(B_, Q, B_HEADS, B_DH)


def nsa_window_prompt(q, kw, vw):
    B_, T = q.shape[:2]
    qb = WIN_QBLK if T % WIN_QBLK == 0 else T
    span = WINDOW + qb
    kp = jnp.pad(kw, ((0, 0), (WINDOW, 0), (0, 0), (0, 0)))
    vp = jnp.pad(vw, ((0, 0), (WINDOW, 0), (0, 0), (0, 0)))

    def block(i):
        s0 = i * qb
        qi = lax.dynamic_slice_in_dim(q, s0, qb, 1)
        ki = lax.dynamic_slice_in_dim(kp, s0, span, 1)
        vi = lax.dynamic_slice_in_dim(vp, s0, span, 1)
        return window_attend(qi, s0 + jnp.arange(qb), ki, vi, s0 - WINDOW + jnp.arange(span))

    out = lax.map(block, jnp.arange(T // qb))
    return jnp.moveaxis(out, 0, 1).reshape(B_, T, B_HEADS, B_DH)


def nsa_mixer(q, kv_new, gates, hist, win_buf, pos0):
    B_, T = q.shape[:2]
    q = q.astype(f32)
    kv_new = kv_new.astype(f32)
    rows = kv_new[:, :, :2].reshape(B_, T, 4, B_KV, B_DH)
    full = rows if hist is None else jnp.concatenate([hist.astype(f32), rows], axis=1)
    Tk = full.shape[1]
    qpos = pos0 + jnp.arange(T)
    o_cmp, imp = nsa_compressed(q, qpos, full[:, :, 0], full[:, :, 1])
    idx = nsa_select_blocks(imp, qpos, Tk)
    o_sel = nsa_selected(q, qpos, full[:, :, 2], full[:, :, 3], idx)
    win_new = kv_new[:, :, 2]
    if win_buf is None:
        o_win = nsa_window_prompt(q, win_new[:, :, 0], win_new[:, :, 1])
        new_buf = win_new[:, -min(WINDOW, T):]
    else:
        wb = win_buf.shape[1]
        cat = jnp.concatenate([win_buf.astype(f32), win_new], axis=1)
        kpos = pos0 - wb + jnp.arange(wb + T)
        o_win = window_attend(q, qpos, cat[:, :, 0], cat[:, :, 1], kpos)
        new_buf = cat[:, -min(WINDOW, wb + T):]
    o = gates[..., 0:1] * o_cmp + gates[..., 1:2] * o_sel + gates[..., 2:3] * o_win
    return o, rows, new_buf


def even_mixer(x, w_in, conv_w, A_log, dt_bias, dn_g, w_out, conv_buf, S0, hist, win_buf, pos0):
    B_, T, _ = x.shape
    h = x @ w_in
    qkv_a, beta_a, a_a, gate_a, q_b, kv_b, g_b = split_cols(h, EVEN_SIZES)
    conv, new_conv = causal_conv(qkv_a, conv_buf.astype(x.dtype), conv_w)
    conv = jax.nn.silu(conv.astype(f32))
    qa, ka, va = split_cols(conv, (A_QK, A_QK, A_WIDTH))
    qa = l2_normalize(qa.reshape(B_, T, A_HEADS, A_DK))
    ka = l2_normalize(ka.reshape(B_, T, A_HEADS, A_DK))
    va = va.reshape(B_, T, A_HEADS, A_DV)
    beta = jax.nn.sigmoid(beta_a.astype(f32))
    g = -jnp.exp(A_log.astype(f32)) * jax.nn.softplus(a_a.astype(f32) + dt_bias.astype(f32))
    o_a, S_new = gated_delta_chunked(qa, ka, va, g, beta, S0)
    o_a = rms_norm(o_a, dn_g) * jax.nn.silu(gate_a.astype(f32).reshape(B_, T, A_HEADS, A_DV))
    o_b, rows, new_buf = nsa_mixer(q_b.reshape(B_, T, B_HEADS, B_DH),
                                   kv_b.reshape(B_, T, N_BRANCH, 2, B_KV, B_DH),
                                   jax.nn.sigmoid(g_b.astype(f32)).reshape(B_, T, B_HEADS, N_BRANCH),
                                   hist, win_buf, pos0)
    mixed = jnp.concatenate([o_a.reshape(B_, T, A_WIDTH), o_b.reshape(B_, T, B_WIDTH)], axis=-1).astype(x.dtype)
    dt = x.dtype
    return mixed @ w_out, rows.astype(dt), new_buf.astype(dt), new_conv.astype(dt), S_new.astype(dt)


def odd_mixer(x, w_in, w_g2, b_g2, gn_g, w_out, S0):
    B_, T, _ = x.shape
    h = (x @ w_in).astype(f32)
    q, k, v, g1, r = split_cols(h, ODD_SIZES)
    log_a = jax.nn.log_sigmoid(g1 @ w_g2.astype(f32) + b_g2.astype(f32)) / GLA_TAU
    o, S_new = gla_chunked(q.reshape(B_, T, C_HEADS, C_DK), k.reshape(B_, T, C_HEADS, C_DK),
                           v.reshape(B_, T, C_HEADS, C_DV), log_a.reshape(B_, T, C_HEADS, C_DK), S0)
    o = rms_norm(o, gn_g) * jax.nn.silu(r.reshape(B_, T, C_HEADS, C_DV))
    return o.reshape(B_, T, C_WIDTH).astype(x.dtype) @ w_out, S_new.astype(x.dtype)


def swiglu(x, wg, wu, wd):
    return (jax.nn.silu(x @ wg) * (x @ wu)) @ wd


def setup_inputs(seed: int = 0) -> dict:
    key = jax.random.key(seed)
    keys = iter(jax.random.split(key, 40))

    def nrm(shape, scale):
        return jax.random.normal(next(keys), shape, jnp.float32) * scale

    n_pages = PAST_LEN // PAGE_SIZE
    used = DEC_BATCH * n_pages
    n_pool = used + max(1, used // 4)
    page_table = jax.random.permutation(next(keys), n_pool)[:used].reshape(DEC_BATCH, n_pages).astype(jnp.int32)
    w_buf = min(WINDOW, PAST_LEN)
    dt = jnp.exp(jax.random.uniform(next(keys), (N_EVEN, A_HEADS), jnp.float32, math.log(1e-3), math.log(1e-1)))
    dt_bias = dt + jnp.log(-jnp.expm1(-dt))
    a_log = jnp.log(jax.random.uniform(next(keys), (N_EVEN, A_HEADS), jnp.float32, 1.0, 16.0))
    mix_even = A_WIDTH + B_WIDTH
    return {
        'x_prompt': nrm((BATCH, SEQ, D_MODEL), 1.0),
        'x_sample': nrm((DEC_BATCH, DEC_SEQ, D_MODEL), 1.0),
        'cache_nsa_kv': nrm((n_pool, N_EVEN, PAGE_SIZE, 4, B_KV, B_DH), 1.0),
        'state_nsa_win': nrm((N_EVEN, DEC_BATCH, w_buf, 2, B_KV, B_DH), 1.0),
        'state_delta_conv': nrm((N_EVEN, DEC_BATCH, CONV_W - 1, A_CONV_CH), 1.0),
        'state_delta_S': nrm((N_EVEN, DEC_BATCH, A_HEADS, A_DK, A_DV), 0.1),
        'state_gla_S': nrm((N_ODD, DEC_BATCH, C_HEADS, C_DK, C_DV), 1.0),
        'page_table': page_table,
        'w_in_even': nrm((N_EVEN, D_MODEL, EVEN_IN), D_MODEL ** -0.5),
        'conv_w_delta': nrm((N_EVEN, CONV_W, A_CONV_CH), CONV_W ** -0.5),
        'delta_A_log': a_log,
        'delta_dt_bias': dt_bias,
        'delta_norm_g': 1.0 + nrm((N_EVEN, A_DV), 0.02),
        'w_out_even': nrm((N_EVEN, mix_even, D_MODEL), BETA * mix_even ** -0.5),
        'w_in_odd': nrm((N_ODD, D_MODEL, ODD_IN), D_MODEL ** -0.5),
        'w_gla_gate2': nrm((N_ODD, C_LOWRANK, C_QK), C_LOWRANK ** -0.5),
        'b_gla_gate2': nrm((N_ODD, C_QK), 0.02),
        'gla_norm_g': 1.0 + nrm((N_ODD, C_DV), 0.02),
        'w_out_odd': nrm((N_ODD, C_WIDTH, D_MODEL), BETA * C_WIDTH ** -0.5),
        'w_ffn_gate': nrm((DEPTH, D_MODEL, D_FF), D_MODEL ** -0.5),
        'w_ffn_up': nrm((DEPTH, D_MODEL, D_FF), BETA * D_MODEL ** -0.5),
        'w_ffn_down': nrm((DEPTH, D_FF, D_MODEL), BETA * D_FF ** -0.5),
        'ln_g': 1.0 + nrm((DEPTH, 2, D_MODEL), 0.02),
        'ln_b': nrm((DEPTH, 2, D_MODEL), 0.02),
    }


def reference(x_prompt, x_sample, cache_nsa_kv, state_nsa_win, state_delta_conv, state_delta_S, state_gla_S,
              page_table, w_in_even, conv_w_delta, delta_A_log, delta_dt_bias, delta_norm_g, w_out_even,
              w_in_odd, w_gla_gate2, b_gla_gate2, gla_norm_g, w_out_odd, w_ffn_gate, w_ffn_up, w_ffn_down,
              ln_g, ln_b):
    past = page_table.shape[1] * PAGE_SIZE
    dec_b = x_sample.shape[0]
    bp = x_prompt.shape[0]
    xp, xs = x_prompt, x_sample
    p_rows, p_win, p_conv, p_dS, p_gS = [], [], [], [], []
    s_rows, s_win, s_conv, s_dS, s_gS = [], [], [], [], []
    for layer in range(DEPTH):
        li = layer // 2
        if layer % 2 == 0:
            wts = (w_in_even[li], conv_w_delta[li], delta_A_log[li], delta_dt_bias[li], delta_norm_g[li], w_out_even[li])
            conv0 = jnp.zeros((bp, CONV_W - 1, A_CONV_CH), xp.dtype)
            S0 = jnp.zeros((bp, A_HEADS, A_DK, A_DV), f32)
            yp, rows, win, conv, dS = even_mixer(xp, *wts, conv0, S0, None, None, 0)
            p_rows.append(rows); p_win.append(win); p_conv.append(conv); p_dS.append(dS)
            hist = cache_nsa_kv[page_table, li].reshape(dec_b, past, 4, B_KV, B_DH)
            ys, rows, win, conv, dS = even_mixer(xs, *wts, state_delta_conv[li], state_delta_S[li], hist,
                                                 state_nsa_win[li], past)
            s_rows.append(rows); s_win.append(win); s_conv.append(conv); s_dS.append(dS)
        else:
            wts = (w_in_odd[li], w_gla_gate2[li], b_gla_gate2[li], gla_norm_g[li], w_out_odd[li])
            yp, gS = odd_mixer(xp, *wts, jnp.zeros((bp, C_HEADS, C_DK, C_DV), f32))
            p_gS.append(gS)
            ys, gS = odd_mixer(xs, *wts, state_gla_S[li])
            s_gS.append(gS)
        xp = layer_norm(ALPHA * xp + yp, ln_g[layer, 0], ln_b[layer, 0])
        xs = layer_norm(ALPHA * xs + ys, ln_g[layer, 0], ln_b[layer, 0])
        xp = layer_norm(ALPHA * xp + swiglu(xp, w_ffn_gate[layer], w_ffn_up[layer], w_ffn_down[layer]), ln_g[layer, 1], ln_b[layer, 1])
        xs = layer_norm(ALPHA * xs + swiglu(xs, w_ffn_gate[layer], w_ffn_up[layer], w_ffn_down[layer]), ln_g[layer, 1], ln_b[layer, 1])
    return (xp, xs,
            jnp.stack(p_rows), jnp.stack(p_win), jnp.stack(p_conv), jnp.stack(p_dS), jnp.stack(p_gS),
            jnp.stack(s_rows), jnp.stack(s_win), jnp.stack(s_conv), jnp.stack(s_dS), jnp.stack(s_gS))
```

```cpp
#include <hip/hip_runtime.h>
#include <hip/hip_cooperative_groups.h>
#include <cstdio>
#include <cstdint>
namespace cg = cooperative_groups;

#define LAS __attribute__((address_space(3)))
#define GAS __attribute__((address_space(1)))
#define DI __device__ __forceinline__
typedef unsigned short bf16;
typedef short bf16x8 __attribute__((ext_vector_type(8)));
typedef short s16x4 __attribute__((ext_vector_type(4)));
typedef float f32x4 __attribute__((ext_vector_type(4)));
typedef float f32x2 __attribute__((ext_vector_type(2)));
typedef float f32x16 __attribute__((ext_vector_type(16)));
typedef unsigned u32x4 __attribute__((ext_vector_type(4)));
typedef unsigned u32x2 __attribute__((ext_vector_type(2)));

constexpr int DM = 1024, NB = 8, SEQ = 2048, MP = NB * SEQ, DB = 32, MT = 16640  ;
constexpr int NE = 3584, NO = 3328, DFF = 2816, NGU = 5632;
constexpr int PAST = 8192, NPAGE = 64;
constexpr float ALPHA = 1.41421356237f;
constexpr int CE_QKV = 0, CE_GATE = 1536, CE_QB = 2048, CE_KV = 2560, CE_SMALL = 3328;
constexpr int CO_Q = 0, CO_K = 512, CO_V = 1024, CO_R = 2048, CO_G1 = 3072;

enum { I_XP = 0, I_XS, I_CACHE, I_WINST, I_DCONV, I_DS, I_GS, I_PT, I_WINE, I_CONVW, I_ALOG, I_DTB, I_DNG, I_WOE, I_WINO, I_WG2, I_BG2, I_GNG, I_WOO, I_FG, I_FU, I_FD, I_LNG, I_LNB, N_IN };

constexpr size_t O_YP = 0, O_YS = O_YP + (size_t)MP * DM, O_ROWS_P = O_YS + (size_t)DB * DM, O_WIN_P = O_ROWS_P + (size_t)MP * 512,
    O_DCONV_P = O_WIN_P + (size_t)NB * 512 * 256, O_DS_P = O_DCONV_P + (size_t)NB * 3 * 1536, O_GS_P = O_DS_P + (size_t)NB * 4 * 128 * 128,
    O_ROWS_S = O_GS_P + (size_t)NB * 4 * 128 * 256, O_WIN_S = O_ROWS_S + (size_t)DB * 512, O_DCONV_S = O_WIN_S + (size_t)DB * 512 * 256,
    O_DS_S = O_DCONV_S + (size_t)DB * 3 * 1536, O_GS_S = O_DS_S + (size_t)DB * 4 * 128 * 128, O_END = O_GS_S + (size_t)DB * 4 * 128 * 256;
static_assert(O_END == 38506496, "output size");

constexpr size_t MiB = 1u << 20;
constexpr size_t al(size_t x) { return (x + MiB - 1) & ~(MiB - 1); }
constexpr size_t WS_CTL = 0, CTL_BYTES = MiB;
constexpr size_t WS_WINE = WS_CTL + CTL_BYTES;
constexpr size_t WS_WOE = WS_WINE + al((size_t)NE * DM * 2);
constexpr size_t WS_WINO = WS_WOE + al((size_t)DM * DM * 2);
constexpr size_t WS_WOO = WS_WINO + al((size_t)NO * DM * 2);
constexpr size_t WS_WGU = WS_WOO + al((size_t)DM * DM * 2);
constexpr size_t WS_WD = WS_WGU + 2 * al((size_t)NGU * DM * 2);
constexpr size_t WS_XB = WS_WD + 2 * al((size_t)DM * DFF * 2);
constexpr size_t WS_H = WS_XB + al((size_t)MT * DM * 2);
constexpr size_t WS_HS = WS_H + al((size_t)MT * NE * 2);
constexpr size_t WS_MIX = WS_HS + al((size_t)MT * 32 * 4);
constexpr size_t WS_Y = WS_MIX + al((size_t)MT * DM * 2);
constexpr size_t WS_X1 = WS_Y + al((size_t)MT * DM * 4);
constexpr size_t WS_FF = WS_X1 + al((size_t)MT * DM * 4);
constexpr size_t WS_KCBP = WS_FF + al((size_t)MT * DFF * 2);
constexpr size_t WS_KCBS = WS_KCBP + al((size_t)NB * 64 * 256 * 4);
constexpr size_t WS_CHK = WS_KCBS + al((size_t)DB * 256 * 256 * 4);
constexpr size_t CHK_BYTES = 81920;
constexpr size_t WS_END = WS_CHK + al((size_t)1024 * CHK_BYTES);

constexpr int NTHREADS = 512, NWAVES = 8;
constexpr int LDS_BYTES = 147456;

DI unsigned f2bf(float f) { unsigned u = __builtin_bit_cast(unsigned, f); return (u + 0x7fffu + ((u >> 16) & 1u)) >> 16; }
DI unsigned pk2(float lo, float hi) { return f2bf(lo) | (f2bf(hi) << 16); }
DI float bf2f(bf16 v) { return __builtin_bit_cast(float, (unsigned)v << 16); }
DI float bflo(unsigned w) { return __builtin_bit_cast(float, w << 16); }
DI float bfhi(unsigned w) { return __builtin_bit_cast(float, w & 0xffff0000u); }
DI float sigmoidf_(float x) { return 1.f / (1.f + __expf(-x)); }
DI float siluf_(float x) { return x / (1.f + __expf(-x)); }
DI float wave_sum(float v) {
#pragma unroll
    for (int o = 1; o < 64; o <<= 1) v += __shfl_xor(v, o);
    return v; }
DI float wave_max(float v) {
#pragma unroll
    for (int o = 1; o < 64; o <<= 1) v = fmaxf(v, __shfl_xor(v, o));
    return v; }
#define LDS_WAIT() asm volatile("s_waitcnt lgkmcnt(0)" ::: "memory")
#define VM_WAIT() asm volatile("s_waitcnt vmcnt(0)" ::: "memory")
namespace pg8 {
#define PG8_LAS __attribute__((address_space(3)))
typedef unsigned short bf16_t;
typedef short bf16x8 __attribute__((ext_vector_type(8)));
typedef float f32x4 __attribute__((ext_vector_type(4)));
typedef unsigned u32x4 __attribute__((ext_vector_type(4)));
constexpr int BM = 256, BK = 64, HALF = 128, HTB = HALF * BK * 2  , STAGE_BYTES = 8 * HTB, NXCD = 8, WGM = 8;

__host__ __device__ __forceinline__ int lds_byte(int r, int c) { const int st = (r >> 4) * 2 + (c >> 5), rr = r & 15, cc = c & 31, ob = rr * 64 + cc * 2; return st * 1024 + (ob ^ (((ob >> 9) & 1) << 5)); }
__host__ __device__ __forceinline__ void stage_rc(int b, int& R, int& C) { const int st = b / 1024, sb = b % 1024, swz = sb ^ (((sb >> 9) & 1) << 5); R = (st >> 1) * 16 + swz / 64; C = (st & 1) * 32 + (swz % 64) / 2; }
__host__ __device__ __forceinline__ int perm32(int rho) { const int n = rho >> 4, i = rho & 15; return 8 * (i >> 2) + 4 * n + (i & 3); }

struct Unit { int pm, pn; };
struct Gemm { const bf16_t* A; const bf16_t* Bt; int M, N, K; };

struct StaticOrder {
    int nM, nN, nwg, G, c;
    __host__ __device__ void init(int M, int N, int G_, int c_) { nM = M / BM; nN = N / BM; nwg = nM * nN; G = G_; c = c_; }
    __host__ __device__ bool next(int i, Unit& u) const {
        const long L = (long)i * G + c; if (L >= nwg) return false;
        int wgid = (int)L; { const int q = nwg / NXCD, r = nwg % NXCD, xcd = wgid % NXCD, off = wgid / NXCD; wgid = (xcd < r ? xcd * (q + 1) : r * (q + 1) + (xcd - r) * q) + off; }
        const int nig = WGM * nN, gid = wgid / nig, fm = gid * WGM, gsz = (nM - fm) < WGM ? (nM - fm) : WGM;
        u.pm = fm + ((wgid % nig) % gsz); u.pn = (wgid % nig) / gsz; return true;
    }
    __device__ __forceinline__ void a_ready(const Unit&) const {}
    __device__ __forceinline__ void done(const Unit&) const {}
};
__device__ __forceinline__ unsigned cvt_pk_bf16(float lo, float hi) { unsigned r; asm volatile("v_cvt_pk_bf16_f32 %0, %1, %2" : "=v"(r) : "v"(lo), "v"(hi)); return r; }
__device__ __forceinline__ u32x4 pack8(f32x4 v0, f32x4 v1) { u32x4 w; w.x = cvt_pk_bf16(v0[0], v0[1]); w.y = cvt_pk_bf16(v0[2], v0[3]); w.z = cvt_pk_bf16(v1[0], v1[1]); w.w = cvt_pk_bf16(v1[2], v1[3]); return w; }

struct EpiInE {
    static constexpr bool PERM = true, AFTER_DRAIN = false;
    bf16_t* H; float* HS; float* out;
    __device__ __forceinline__ void operator()(const f32x4 (&acc)[2][2][4][2], const Unit& u, int wr, int wc, int fr, int fq) const {
        const int row0 = u.pm * BM + wr * 64 + fr, col0 = u.pn * BM + wc * 32 + 8 * fq, pn = u.pn;
#pragma unroll
        for (int ai = 0; ai < 2; ++ai)
#pragma unroll
            for (int m = 0; m < 4; ++m) { const int r = row0 + ai * HALF + m * 16;
#pragma unroll
                for (int bj = 0; bj < 2; ++bj) { const int c = col0 + bj * HALF; const f32x4 v0 = acc[ai][bj][m][0], v1 = acc[ai][bj][m][1];
                    *(u32x4*)(H + (size_t)r * NE + c) = pack8(v0, v1);
                    float* dst = nullptr;
                    if (pn < 6) { if (r < MP) { const int t = r & (SEQ - 1); if (t >= SEQ - 3) dst = out + O_DCONV_P + ((size_t)(r >> 11) * 3 + (t - (SEQ - 3))) * 1536 + c; }
                                  else if (r < MP + DB) dst = out + O_DCONV_S + ((size_t)(r - MP) * 3 + 2) * 1536 + c; }
                    else if (pn == 10 || pn == 11) { const int cc = c - CE_KV; if (r < MP) dst = out + O_ROWS_P + (size_t)r * 512 + cc; else if (r < MP + DB) dst = out + O_ROWS_S + (size_t)(r - MP) * 512 + cc; }
                    else if (pn == 12) { const int cc = c - (CE_KV + 512); if (r < MP) { const int t = r & (SEQ - 1); if (t >= SEQ - 512) dst = out + O_WIN_P + ((size_t)(r >> 11) * 512 + (t - (SEQ - 512))) * 256 + cc; }
                                         else if (r < MP + DB) dst = out + O_WIN_S + ((size_t)(r - MP) * 512 + 511) * 256 + cc; }
                    else if (pn == 13) { const int cc = c - CE_SMALL; if (cc < 32 && r < MP + DB) dst = HS + (size_t)r * 32 + cc; }
                    if (dst) { *(f32x4*)dst = v0; *(f32x4*)(dst + 4) = v1; } } }
    }
};
struct EpiInO {
    static constexpr bool PERM = true, AFTER_DRAIN = false;
    bf16_t* H; float* HS;
    __device__ __forceinline__ void operator()(const f32x4 (&acc)[2][2][4][2], const Unit& u, int wr, int wc, int fr, int fq) const {
        const int row0 = u.pm * BM + wr * 64 + fr, col0 = u.pn * BM + wc * 32 + 8 * fq, pn = u.pn;
#pragma unroll
        for (int ai = 0; ai < 2; ++ai)
#pragma unroll
            for (int m = 0; m < 4; ++m) { const int r = row0 + ai * HALF + m * 16;
#pragma unroll
                for (int bj = 0; bj < 2; ++bj) { const int c = col0 + bj * HALF; const f32x4 v0 = acc[ai][bj][m][0], v1 = acc[ai][bj][m][1];
                    *(u32x4*)(H + (size_t)r * NO + c) = pack8(v0, v1);
                    if (pn == 12) { const int cc = c - CO_G1; if (cc < 16 && r < MP + DB) { float* dst = HS + (size_t)r * 32 + cc; *(f32x4*)dst = v0; *(f32x4*)(dst + 4) = v1; } } } }
    }
};
struct EpiF32 {
    static constexpr bool PERM = false, AFTER_DRAIN = false;
    float* Y;
    __device__ __forceinline__ void operator()(const f32x4 (&acc)[2][2][4][2], const Unit& u, int wr, int wc, int fr, int fq) const {
        const int row0 = u.pm * BM + wr * 64 + fr, col0 = u.pn * BM + wc * 32 + 4 * fq;
#pragma unroll
        for (int ai = 0; ai < 2; ++ai)
#pragma unroll
            for (int m = 0; m < 4; ++m) { float* rowp = Y + (size_t)(row0 + ai * HALF + m * 16) * DM + col0;
#pragma unroll
                for (int bj = 0; bj < 2; ++bj)
#pragma unroll
                    for (int n = 0; n < 2; ++n) *(f32x4*)(rowp + bj * HALF + n * 16) = acc[ai][bj][m][n]; }
    }
};
struct EpiGU {
    static constexpr bool PERM = true, AFTER_DRAIN = false;
    bf16_t* FF;
    __device__ __forceinline__ void operator()(const f32x4 (&acc)[2][2][4][2], const Unit& u, int wr, int wc, int fr, int fq) const {
        const int row0 = u.pm * BM + wr * 64 + fr, col0 = u.pn * HALF + wc * 32 + 8 * fq;
#pragma unroll
        for (int ai = 0; ai < 2; ++ai)
#pragma unroll
            for (int m = 0; m < 4; ++m) { f32x4 o[2];
#pragma unroll
                for (int n = 0; n < 2; ++n) { const f32x4 g = acc[ai][0][m][n], up = acc[ai][1][m][n];
#pragma unroll
                    for (int i = 0; i < 4; ++i) o[n][i] = g[i] / (1.f + __expf(-g[i])) * up[i]; }
                *(u32x4*)(FF + (size_t)(row0 + ai * HALF + m * 16) * DFF + col0) = pack8(o[0], o[1]); }
    }
};
template <class Epi, class Sched, bool ALIGN_EPI = false, bool SP2 = false>
__device__ __forceinline__ void gemm_phase(PG8_LAS unsigned char* lds, const Gemm g, const Sched& S, const Epi& E) {
    const int tid = threadIdx.x, wid = __builtin_amdgcn_readfirstlane(tid >> 6), lane = tid & 63, wr = wid >> 2, wc = wid & 3, fr = lane & 15, fq = lane >> 4;
    const int K = g.K, nt = K / BK;
    unsigned voffA[2], voffB[2];
#pragma unroll
    for (int i = 0; i < 2; ++i) { int R, C; stage_rc(tid * 16 + i * 8192, R, C); const int Rb = Epi::PERM ? ((R & ~31) + perm32(R & 31)) : R;
        voffA[i] = (unsigned)(R * K + C) * 2u; voffB[i] = (unsigned)(Rb * K + C) * 2u; }
    const size_t kstep = (size_t)(BK * 2);
    const size_t hstep = (size_t)HALF * K * 2;
    const size_t tstep = 2 * hstep;
    const unsigned ldsw = (unsigned)wid * 1024u;
    const int aoff = lds_byte(wr * 64 + fr, fq * 8), boff = lds_byte(wc * 32 + fr, fq * 8);
#define PG8_SA(b, h) (((b) * 2 + (h)) * HTB)
#define PG8_SB(b, h) ((4 + (b) * 2 + (h)) * HTB)
#define PG8_STAGE(bufoff, gbase, voff) do { _Pragma("unroll") for (int _i = 0; _i < 2; ++_i) \
        __builtin_amdgcn_global_load_lds((const unsigned*)((const char*)(gbase) + (voff)[_i]), (PG8_LAS unsigned*)(lds + (bufoff) + ldsw + _i * 8192), 16, 0, 0); } while (0)
#define PG8_LDA(dst, b, h) do { _Pragma("unroll") for (int m = 0; m < 4; ++m) _Pragma("unroll") for (int k = 0; k < 2; ++k) dst[m][k] = *(const PG8_LAS bf16x8*)(lds + PG8_SA(b, h) + aoff + m * 2048 + k * 1024); } while (0)
#define PG8_LDB(dst, b, h) do { _Pragma("unroll") for (int n = 0; n < 2; ++n) _Pragma("unroll") for (int k = 0; k < 2; ++k) dst[n][k] = *(const PG8_LAS bf16x8*)(lds + PG8_SB(b, h) + boff + n * 2048 + k * 1024); } while (0)
#define PG8_MMA(ai, bj, At, Bt) do { __builtin_amdgcn_s_setprio(1); _Pragma("unroll") for (int m = 0; m < 4; ++m) _Pragma("unroll") for (int n = 0; n < 2; ++n) _Pragma("unroll") for (int k = 0; k < 2; ++k) \
        acc[ai][bj][m][n] = __builtin_amdgcn_mfma_f32_16x16x32_bf16(Bt[n][k], At[m][k], acc[ai][bj][m][n], 0, 0, 0); __builtin_amdgcn_s_setprio(0); } while (0)
#define PG8_WAIT_V(n) asm volatile("s_waitcnt vmcnt(" #n ")" ::: "memory")
#define PG8_WAIT_L(n) asm volatile("s_waitcnt lgkmcnt(" #n ")" ::: "memory")
#define PG8_BAR __builtin_amdgcn_s_barrier()
#define PG8_SCHED __builtin_amdgcn_sched_barrier(0)
    Unit cur, nxt; int ui = 0;
    if (!S.next(0, cur)) return;
    f32x4 acc[2][2][4][2];
#pragma unroll
    for (int a = 0; a < 2; ++a)
#pragma unroll
        for (int b = 0; b < 2; ++b)
#pragma unroll
            for (int m = 0; m < 4; ++m)
#pragma unroll
                for (int n = 0; n < 2; ++n) acc[a][b][m][n] = (f32x4){0.f, 0.f, 0.f, 0.f};
    bf16x8 At[4][2], B0[2][2], B1[2][2];
    const char* cA = (const char*)g.A + (size_t)cur.pm * tstep; const char* cB = (const char*)g.Bt + (size_t)cur.pn * tstep;
    S.a_ready(cur);
    if constexpr (SP2) {
        PG8_STAGE(PG8_SB(0, 0), cB, voffB); PG8_STAGE(PG8_SB(0, 1), cB + hstep, voffB); PG8_STAGE(PG8_SA(0, 0), cA, voffA); PG8_STAGE(PG8_SA(0, 1), cA + hstep, voffA);
        if (wr == 1) PG8_BAR;
        PG8_WAIT_V(2); PG8_BAR;
        PG8_STAGE(PG8_SB(1, 0), cB + kstep, voffB); PG8_STAGE(PG8_SA(1, 0), cA + kstep, voffA); PG8_STAGE(PG8_SB(1, 1), cB + hstep + kstep, voffB);
        PG8_WAIT_V(6); PG8_BAR;
    } else {
        PG8_STAGE(PG8_SB(0, 0), cB, voffB); PG8_STAGE(PG8_SA(0, 0), cA, voffA); PG8_STAGE(PG8_SB(0, 1), cB + hstep, voffB); PG8_STAGE(PG8_SA(0, 1), cA + hstep, voffA);
        if (wr == 1) PG8_BAR;
        PG8_WAIT_V(4); PG8_BAR;
        PG8_STAGE(PG8_SB(1, 0), cB + kstep, voffB); PG8_STAGE(PG8_SA(1, 0), cA + kstep, voffA); PG8_STAGE(PG8_SB(1, 1), cB + hstep + kstep, voffB);
        PG8_WAIT_V(6); PG8_BAR;
    }
    for (;;) {
        const bool has_next = S.next(ui + 1, nxt);
        const char* nA = has_next ? (const char*)g.A + (size_t)nxt.pm * tstep : cA; const char* nB = has_next ? (const char*)g.Bt + (size_t)nxt.pn * tstep : cB;
        for (int t = 0; t < nt; t += 2) {
            const bool last = (t == nt - 2);
            const char* a1 = cA + (size_t)(t + 1) * kstep;
            const char* a2 = last ? nA : cA + (size_t)(t + 2) * kstep; const char* b2 = last ? nB : cB + (size_t)(t + 2) * kstep;
            const char* a3 = a2 + kstep; const char* b3 = b2 + kstep;
            if (last && has_next) S.a_ready(nxt);
            if constexpr (SP2) {
            PG8_LDB(B0, 0, 0); PG8_LDB(B1, 0, 1); PG8_SCHED; PG8_LDA(At, 0, 0); PG8_STAGE(PG8_SA(1, 1), a1 + hstep, voffA);
            PG8_WAIT_V(8); PG8_WAIT_L(0); PG8_BAR; PG8_MMA(0, 0, At, B0); PG8_MMA(0, 1, At, B1); PG8_BAR; PG8_SCHED;
            PG8_LDA(At, 0, 1); PG8_STAGE(PG8_SB(0, 0), b2, voffB); PG8_STAGE(PG8_SB(0, 1), b2 + hstep, voffB); PG8_STAGE(PG8_SA(0, 0), a2, voffA);
            PG8_WAIT_V(8); PG8_WAIT_L(0); PG8_BAR; PG8_MMA(1, 0, At, B0); PG8_MMA(1, 1, At, B1); PG8_BAR; PG8_SCHED;
            PG8_LDB(B0, 1, 0); PG8_LDB(B1, 1, 1); PG8_SCHED; PG8_LDA(At, 1, 0); PG8_STAGE(PG8_SA(0, 1), a2 + hstep, voffA);
            PG8_WAIT_V(8); PG8_WAIT_L(0); PG8_BAR; PG8_MMA(0, 0, At, B0); PG8_MMA(0, 1, At, B1); PG8_BAR; PG8_SCHED;
            PG8_LDA(At, 1, 1); PG8_STAGE(PG8_SB(1, 0), b3, voffB); PG8_STAGE(PG8_SB(1, 1), b3 + hstep, voffB); PG8_STAGE(PG8_SA(1, 0), a3, voffA);
            PG8_WAIT_V(8); PG8_WAIT_L(0); PG8_BAR; PG8_MMA(1, 0, At, B0); PG8_MMA(1, 1, At, B1); PG8_BAR; PG8_SCHED;
            } else {
            PG8_LDB(B0, 0, 0); PG8_SCHED; PG8_LDA(At, 0, 0); PG8_STAGE(PG8_SA(1, 1), a1 + hstep, voffA);
            PG8_WAIT_L(8); PG8_BAR; PG8_WAIT_L(0); PG8_MMA(0, 0, At, B0); PG8_BAR; PG8_SCHED;
            PG8_LDB(B1, 0, 1); PG8_STAGE(PG8_SB(0, 0), b2, voffB);
            PG8_BAR; PG8_WAIT_L(0); PG8_MMA(0, 1, At, B1); PG8_BAR;
            PG8_LDA(At, 0, 1); PG8_STAGE(PG8_SA(0, 0), a2, voffA);
            PG8_BAR; PG8_WAIT_L(0); PG8_MMA(1, 0, At, B0); PG8_BAR; PG8_SCHED;
            PG8_STAGE(PG8_SB(0, 1), b2 + hstep, voffB);
            PG8_WAIT_V(6); PG8_BAR; PG8_MMA(1, 1, At, B1); PG8_BAR;
            PG8_LDB(B0, 1, 0); PG8_SCHED; PG8_LDA(At, 1, 0); PG8_STAGE(PG8_SA(0, 1), a2 + hstep, voffA);
            PG8_WAIT_L(8); PG8_BAR; PG8_WAIT_L(0); PG8_MMA(0, 0, At, B0); PG8_BAR; PG8_SCHED;
            PG8_LDB(B1, 1, 1); PG8_STAGE(PG8_SB(1, 0), b3, voffB);
            PG8_BAR; PG8_WAIT_L(0); PG8_MMA(0, 1, At, B1); PG8_BAR;
            PG8_LDA(At, 1, 1); PG8_STAGE(PG8_SA(1, 0), a3, voffA);
            PG8_BAR; PG8_WAIT_L(0); PG8_MMA(1, 0, At, B0); PG8_BAR; PG8_SCHED;
            PG8_STAGE(PG8_SB(1, 1), b3 + hstep, voffB);
            PG8_WAIT_V(6); PG8_BAR; PG8_MMA(1, 1, At, B1); PG8_BAR;
            }
        }
        if constexpr (ALIGN_EPI) { if (wr == 0) PG8_BAR; }
        if constexpr (!Epi::AFTER_DRAIN) { E(acc, cur, wr, wc, fr, fq); S.done(cur); }
        if (!has_next) break;
#pragma unroll
        for (int a = 0; a < 2; ++a)
#pragma unroll
            for (int b = 0; b < 2; ++b)
#pragma unroll
                for (int m = 0; m < 4; ++m)
#pragma unroll
                    for (int n = 0; n < 2; ++n) acc[a][b][m][n] = (f32x4){0.f, 0.f, 0.f, 0.f};
        cur = nxt; cA = nA; cB = nB; ++ui;
        if constexpr (ALIGN_EPI) { if (wr == 1) PG8_BAR; }
    }
    PG8_WAIT_V(0);
    if constexpr (!ALIGN_EPI) { if (wr == 0) PG8_BAR; }
    PG8_BAR;
    if constexpr (Epi::AFTER_DRAIN) { E.fused(acc, cur, wr, wc, fr, fq, lds, wid, lane); S.done(cur); }
#undef PG8_SA
#undef PG8_SB
#undef PG8_STAGE
#undef PG8_LDA
#undef PG8_LDB
#undef PG8_MMA
#undef PG8_WAIT_V
#undef PG8_WAIT_L
#undef PG8_BAR
#undef PG8_SCHED
}
}
struct Args { const void* in[N_IN]; float* out; unsigned char* ws; int ph_lo, ph_hi; };

struct Ctx {
    LAS unsigned char* lds; int tid, lane, wave, G, bid;
};

DI const float* w_src(const Args& a, int m, int n, int& ld) {
    switch (m) {
    case 0: { ld = 3360; const float* W = (const float*)a.in[I_WINE]; int s;
              if (n < 1536) s = n; else if (n < CE_SMALL) s = n + 8; else if (n < CE_SMALL + 8) s = n - CE_SMALL + 1536; else if (n < 3360) s = n; else return nullptr;
              return W + s; }
    case 1: ld = DM; return (const float*)a.in[I_WOE] + n;
    case 2: { ld = 3088; const float* W = (const float*)a.in[I_WINO]; int s;
              if (n < 2048) s = n; else if (n < 3072) s = n + 16; else if (n < 3088) s = n - 3072 + 2048; else return nullptr;
              return W + s; }
    case 3: ld = DM; return (const float*)a.in[I_WOO] + n;
    case 4: case 5: { ld = DFF; const int l = m - 4, w = n & 255, f = (n >> 8) * 128 + (w & 127);
              return (w < 128 ? (const float*)a.in[I_FG] : (const float*)a.in[I_FU]) + (size_t)l * DM * DFF + f; }
    default: { ld = DM; const int l = m - 6; return (const float*)a.in[I_FD] + (size_t)l * DFF * DM + n; }
    }
}
DI bf16* w_dst(const Args& a, int m) {
    switch (m) {
    case 0: return (bf16*)(a.ws + WS_WINE); case 1: return (bf16*)(a.ws + WS_WOE); case 2: return (bf16*)(a.ws + WS_WINO); case 3: return (bf16*)(a.ws + WS_WOO);
    case 4: return (bf16*)(a.ws + WS_WGU); case 5: return (bf16*)(a.ws + WS_WGU + al((size_t)NGU * DM * 2));
    case 6: return (bf16*)(a.ws + WS_WD); default: return (bf16*)(a.ws + WS_WD + al((size_t)DM * DFF * 2));
    }
}
DI void p0_prologue(const Args& a, const Ctx& C) {
    LAS float* scr = (LAS float*)(C.lds + C.wave * 16384);
    const int gw = C.bid * NWAVES + C.wave, NGW = C.G * NWAVES, lane = C.lane;
    constexpr int IT0 = 16 * (NE / 32), IT1 = 16 * 32, IT2 = 16 * (NO / 32), IT3 = 16 * 32, IT4 = 16 * (NGU / 32), IT6 = (DFF / 64) * 32;
    constexpr int NIT = IT0 + IT1 + IT2 + IT3 + 2 * IT4 + 2 * IT6;
    for (int it = gw; it < NIT; it += NGW) {
        int r = it, m, K = DM, rows;
        if (r < IT0) { m = 0; rows = NE; } else if ((r -= IT0) < IT1) { m = 1; rows = DM; } else if ((r -= IT1) < IT2) { m = 2; rows = NO; } else if ((r -= IT2) < IT3) { m = 3; rows = DM; }
        else if ((r -= IT3) < IT4) { m = 4; rows = NGU; } else if ((r -= IT4) < IT4) { m = 5; rows = NGU; } else if ((r -= IT4) < IT6) { m = 6; rows = DM; K = DFF; } else { r -= IT6; m = 7; rows = DM; K = DFF; }
        const int nblk = rows / 32, kb = r / nblk, nb = r % nblk, k0 = 64 * kb, n0 = 32 * nb;
        int ld; const float* src = w_src(a, m, n0 + (lane & 31), ld);
#pragma unroll 8
        for (int i = 0; i < 32; ++i) { const int kk = 2 * i + (lane >> 5); scr[kk * 33 + (lane & 31)] = src ? src[(size_t)(k0 + kk) * ld] : 0.f; }
        LDS_WAIT(); asm volatile("" ::: "memory");
        const int c = lane & 7; bf16* WT = w_dst(a, m);
#pragma unroll
        for (int j = 0; j < 4; ++j) { const int n = (lane >> 3) + 8 * j; const LAS float* s = scr + (8 * c) * 33 + n;
            u32x4 o; o.x = pk2(s[0 * 33], s[1 * 33]); o.y = pk2(s[2 * 33], s[3 * 33]); o.z = pk2(s[4 * 33], s[5 * 33]); o.w = pk2(s[6 * 33], s[7 * 33]);
            *(u32x4*)(WT + (size_t)(n0 + n) * K + k0 + 8 * c) = o; }
        LDS_WAIT(); asm volatile("" ::: "memory");
    }
    bf16* XB = (bf16*)(a.ws + WS_XB);
    for (int row = gw; row < MT; row += NGW) {
        const float* xr = row < MP ? (const float*)a.in[I_XP] + (size_t)row * DM : row < MP + DB ? (const float*)a.in[I_XS] + (size_t)(row - MP) * DM : nullptr;
#pragma unroll
        for (int j = 0; j < 4; ++j) { f32x4 v = xr ? *(const f32x4*)(xr + 4 * lane + 256 * j) : (f32x4){0.f, 0.f, 0.f, 0.f};
            u32x2 w; w.x = pk2(v[0], v[1]); w.y = pk2(v[2], v[3]); *(u32x2*)(XB + (size_t)row * DM + 4 * lane + 256 * j) = w; }
    }
    const float* cache = (const float*)a.in[I_CACHE]; const int* pt = (const int*)a.in[I_PT]; float* KCBS = (float*)(a.ws + WS_KCBS);
    for (int u = gw; u < DB * 256; u += NGW) {
        const int b = u >> 8, c = u & 255, page = pt[b * NPAGE + (c >> 2)];
        const float* base = cache + ((size_t)page * 128 + (c & 3) * 32) * 512 + 4 * lane;
        f32x4 s = {0.f, 0.f, 0.f, 0.f};
#pragma unroll 8
        for (int i = 0; i < 32; ++i) s += *(const f32x4*)(base + (size_t)i * 512);
        *(f32x4*)(KCBS + (size_t)u * 256 + 4 * lane) = s * (1.f / 32.f);
    }
}

DI void ln_phase(const Args& a, const Ctx& C, int layer, int which) {
    const int gw = C.bid * NWAVES + C.wave, NGW = C.G * NWAVES, lane = C.lane;
    const float* g = (const float*)a.in[I_LNG] + (layer * 2 + which) * DM; const float* bb = (const float*)a.in[I_LNB] + (layer * 2 + which) * DM;
    const float* Y = (const float*)(a.ws + WS_Y); float* X1 = (float*)(a.ws + WS_X1); bf16* XB = (bf16*)(a.ws + WS_XB);
    const bool first = (layer == 0 && which == 0), last = (layer == 1 && which == 1);
    f32x4 gv[4], bv[4];
#pragma unroll
    for (int j = 0; j < 4; ++j) { gv[j] = *(const f32x4*)(g + 4 * lane + 256 * j); bv[j] = *(const f32x4*)(bb + 4 * lane + 256 * j); }
    for (int row = gw; row < MP + DB; row += NGW) {
        const float* xr = first ? (row < MP ? (const float*)a.in[I_XP] + (size_t)row * DM : (const float*)a.in[I_XS] + (size_t)(row - MP) * DM) : X1 + (size_t)row * DM;
        f32x4 v[4]; float s = 0.f;
#pragma unroll
        for (int j = 0; j < 4; ++j) { v[j] = *(const f32x4*)(xr + 4 * lane + 256 * j) * ALPHA + *(const f32x4*)(Y + (size_t)row * DM + 4 * lane + 256 * j); s += (v[j][0] + v[j][1]) + (v[j][2] + v[j][3]); }
        const float mean = wave_sum(s) * (1.f / DM); float q = 0.f;
#pragma unroll
        for (int j = 0; j < 4; ++j) { v[j] = v[j] - mean; q += (v[j][0] * v[j][0] + v[j][1] * v[j][1]) + (v[j][2] * v[j][2] + v[j][3] * v[j][3]); }
        const float rstd = 1.f / sqrtf(wave_sum(q) * (1.f / DM) + 1e-5f);
        float* orow = last ? (row < MP ? a.out + O_YP + (size_t)row * DM : a.out + O_YS + (size_t)(row - MP) * DM) : X1 + (size_t)row * DM;
#pragma unroll
        for (int j = 0; j < 4; ++j) { const f32x4 o = v[j] * rstd * gv[j] + bv[j]; *(f32x4*)(orow + 4 * lane + 256 * j) = o;
            if (!last) { u32x2 w; w.x = pk2(o[0], o[1]); w.y = pk2(o[2], o[3]); *(u32x2*)(XB + (size_t)row * DM + 4 * lane + 256 * j) = w; } }
    }
}
DI int crow(int reg, int h) { return (reg & 3) + 8 * (reg >> 2) + 4 * h; }
template <int K> DI f32x16 mm_tile(const LAS bf16* A, int lda, const LAS bf16* B, int ldb, f32x16 acc, int lane) {
    const int r = lane & 31, h = lane >> 5;
#pragma unroll
    for (int k0 = 0; k0 < K; k0 += 16) {
        const bf16x8 av = *(const LAS bf16x8*)(A + r * lda + k0 + 8 * h);
        const bf16x8 bv = *(const LAS bf16x8*)(B + r * ldb + k0 + 8 * h);
        acc = __builtin_amdgcn_mfma_f32_32x32x16_bf16(av, bv, acc, 0, 0, 0);
    }
    return acc;
}
DI float softplusf_(float x) { return x > 20.f ? x : log1pf(__expf(x)); }
DI float logsigmoidf_(float x) { return fminf(x, 0.f) - log1pf(__expf(-fabsf(x))); }
constexpr int CK_NW = 0, CK_QG = 16384, CK_QK = 32768, CK_KDT = 40960, CK_UT = 57344, CK_GL = 73728;
constexpr int GK_QT = 0, GK_KDT = 16384, GK_ATT = 32768, GK_GL = 40960;
constexpr int LDA = 136, LDT = 72;
DI void delta_chunk_prep(const Args& a, const Ctx& C, int unit) {
    const int b = unit >> 7, h = (unit >> 5) & 3, n = unit & 31, tid = C.tid, lane = C.lane, wave = C.wave;
    const int row0 = b * SEQ + n * 64;
    const bf16* H = (const bf16*)(a.ws + WS_H); const float* HS = (const float*)(a.ws + WS_HS);
    unsigned char* ck = a.ws + WS_CHK + (size_t)unit * CHK_BYTES;
    LAS bf16* Qs = (LAS bf16*)(C.lds); LAS bf16* Ks = (LAS bf16*)(C.lds + 17408); LAS bf16* KBG = (LAS bf16*)(C.lds + 34816); LAS bf16* VBt = (LAS bf16*)(C.lds + 53248);
    LAS float* Am = (LAS float*)(C.lds + 71680); LAS bf16* Ts = (LAS bf16*)(C.lds + 89088); LAS bf16* KDs = (LAS bf16*)(C.lds + 98304);
    LAS float* sm = (LAS float*)(C.lds + 116736);
    if (wave == 0) {
        const float* hs = HS + (size_t)(row0 + lane) * 32;
        const float beta = sigmoidf_(hs[h]);
        float g = -__expf(((const float*)a.in[I_ALOG])[h]) * softplusf_(hs[4 + h] + ((const float*)a.in[I_DTB])[h]);
#pragma unroll
        for (int o = 1; o < 64; o <<= 1) { const float t = __shfl_up(g, o); if (lane >= o) g += t; }
        sm[lane] = beta; sm[64 + lane] = g;
    }
    __syncthreads();
    const float gam_last = sm[64 + 63];
    {
        const float* cw = (const float*)a.in[I_CONVW];
        float wq[4][2], wk[4][2], wv[4][2];
#pragma unroll
        for (int j = 0; j < 4; ++j) { const float* c0 = cw + j * 1536 + h * 128 + 2 * lane;
            wq[j][0] = c0[0]; wq[j][1] = c0[1]; wk[j][0] = c0[512]; wk[j][1] = c0[513]; wv[j][0] = c0[1024]; wv[j][1] = c0[1025]; }
        for (int rr = 0; rr < 8; ++rr) {
            const int i = wave * 8 + rr, t = n * 64 + i;
            float q0 = 0.f, q1 = 0.f, k0 = 0.f, k1 = 0.f, v0 = 0.f, v1 = 0.f;
#pragma unroll
            for (int j = 0; j < 4; ++j) { const int tt = t - 3 + j;
                if (tt >= 0) { const bf16* hr = H + (size_t)(b * SEQ + tt) * NE + h * 128 + 2 * lane;
                    const unsigned xq = *(const unsigned*)(hr), xk = *(const unsigned*)(hr + 512), xv = *(const unsigned*)(hr + 1024);
                    q0 += bflo(xq) * wq[j][0]; q1 += bfhi(xq) * wq[j][1]; k0 += bflo(xk) * wk[j][0]; k1 += bfhi(xk) * wk[j][1]; v0 += bflo(xv) * wv[j][0]; v1 += bfhi(xv) * wv[j][1]; } }
            q0 = siluf_(q0); q1 = siluf_(q1); k0 = siluf_(k0); k1 = siluf_(k1); v0 = siluf_(v0); v1 = siluf_(v1);
            const float qn = rsqrtf(wave_sum(q0 * q0 + q1 * q1) + 1e-6f) * 0.08838834764831845f, kn = rsqrtf(wave_sum(k0 * k0 + k1 * k1) + 1e-6f);
            q0 *= qn; q1 *= qn; k0 *= kn; k1 *= kn;
            const float beta = sm[i], gam = sm[64 + i], eg = __expf(gam), ed = __expf(gam_last - gam);
            *(LAS unsigned*)(Qs + i * LDA + 2 * lane) = pk2(q0, q1);
            *(LAS unsigned*)(Ks + i * LDA + 2 * lane) = pk2(k0, k1);
            KBG[(2 * lane) * LDT + i] = (bf16)f2bf(k0 * beta * eg); KBG[(2 * lane + 1) * LDT + i] = (bf16)f2bf(k1 * beta * eg);
            VBt[(2 * lane) * LDT + i] = (bf16)f2bf(v0 * beta); VBt[(2 * lane + 1) * LDT + i] = (bf16)f2bf(v1 * beta);
            KDs[(2 * lane) * LDT + i] = (bf16)f2bf(k0 * ed); KDs[(2 * lane + 1) * LDT + i] = (bf16)f2bf(k1 * ed);
            *(unsigned*)(ck + CK_QG + (i * 128 + 2 * lane) * 2) = pk2(q0 * eg, q1 * eg);
        }
        if (tid == 0) *(float*)(ck + CK_GL) = __expf(gam_last);
    }
    __syncthreads();
    for (int x = tid; x < 128 * 8; x += NTHREADS) { const int d = x >> 3, c8 = x & 7; *(u32x4*)(ck + CK_KDT + (d * 64 + c8 * 8) * 2) = *(const LAS u32x4*)(KDs + d * LDT + c8 * 8); }
    {
        const int ti = (wave >> 1) & 1, tj = wave & 1, r = lane & 31, hh = lane >> 5; const bool isqk = wave >= 4;
        f32x16 acc = {};
        acc = mm_tile<128>((isqk ? Qs : Ks) + ti * 32 * LDA, LDA, Ks + tj * 32 * LDA, LDA, acc, lane);
        const int j = tj * 32 + r; const float gj = sm[64 + j];
#pragma unroll
        for (int reg = 0; reg < 16; ++reg) { const int i = ti * 32 + crow(reg, hh); const float gi = sm[64 + i];
            if (isqk) { const float v = (i >= j) ? acc[reg] * __expf(gi - gj) : 0.f; *(bf16*)(ck + CK_QK + (i * 64 + j) * 2) = (bf16)f2bf(v); }
            else { const float v = (i > j) ? acc[reg] * sm[i] * __expf(gi - gj) : 0.f; Am[i * 68 + j] = v; } }
    }
    __syncthreads();
    if (wave == 0) {
        float T[64];
#pragma unroll
        for (int i = 0; i < 64; ++i) {
            float acc = (i == lane) ? 1.f : 0.f;
#pragma unroll
            for (int j4 = 0; j4 < i; j4 += 4) { const f32x4 av = *(const LAS f32x4*)(Am + i * 68 + j4);
                acc -= av[0] * T[j4]; if (j4 + 1 < i) acc -= av[1] * T[j4 + 1]; if (j4 + 2 < i) acc -= av[2] * T[j4 + 2]; if (j4 + 3 < i) acc -= av[3] * T[j4 + 3]; }
            T[i] = acc;
            Ts[i * LDT + lane] = (bf16)f2bf(acc);
        }
    }
    __syncthreads();
    {
        const int ti = wave >> 2, tc = wave & 3, r = lane & 31, hh = lane >> 5;
        f32x16 u = {}, w = {};
        u = mm_tile<64>(Ts + ti * 32 * LDT, LDT, VBt + tc * 32 * LDT, LDT, u, lane);
        w = mm_tile<64>(Ts + ti * 32 * LDT, LDT, KBG + tc * 32 * LDT, LDT, w, lane);
        const int col = tc * 32 + r;
#pragma unroll
        for (int g4 = 0; g4 < 4; ++g4) { u32x2 pk; pk.x = pk2(u[4 * g4], u[4 * g4 + 1]); pk.y = pk2(u[4 * g4 + 2], u[4 * g4 + 3]);
            *(u32x2*)(ck + CK_UT + (col * 64 + ti * 32 + 8 * g4 + 4 * hh) * 2) = pk; }
#pragma unroll
        for (int reg = 0; reg < 16; ++reg) { const int i = ti * 32 + crow(reg, hh); *(bf16*)(ck + CK_NW + (i * 128 + col) * 2) = (bf16)f2bf(-w[reg]); }
    }
    __syncthreads();
}
DI void prep_even(const Args& a, const Ctx& C) {
    for (int u = C.bid; u < 1024 + 64; u += C.G) {
        if (u < 1024) delta_chunk_prep(a, C, u);
        else {
            const int item = (u - 1024) * 8 + C.wave, b = item >> 6, cb = item & 63, lane = C.lane;
            const bf16* base = (const bf16*)(a.ws + WS_H) + (size_t)(b * SEQ + cb * 32) * NE + CE_KV + 4 * lane;
            float s0 = 0.f, s1 = 0.f, s2 = 0.f, s3 = 0.f;
#pragma unroll 8
            for (int i = 0; i < 32; ++i) { const u32x2 x = *(const u32x2*)(base + (size_t)i * NE); s0 += bflo(x.x); s1 += bfhi(x.x); s2 += bflo(x.y); s3 += bfhi(x.y); }
            *(f32x4*)((float*)(a.ws + WS_KCBP) + (size_t)item * 256 + 4 * lane) = (f32x4){s0, s1, s2, s3} * (1.f / 32.f);
        }
    }
}
DI void delta_scan(const Args& a, const Ctx& C, int unit) {
    const int b = unit >> 2, h = unit & 3, tid = C.tid, lane = C.lane, wave = C.wave, p = wave >> 1, hf = wave & 1, r = lane & 31, hh = lane >> 5;
    LAS bf16* STs = (LAS bf16*)(C.lds); LAS bf16* NWs = (LAS bf16*)(C.lds + 34816); LAS bf16* QGs = (LAS bf16*)(C.lds + 52224); LAS bf16* QKs = (LAS bf16*)(C.lds + 69632);
    LAS bf16* KDs = (LAS bf16*)(C.lds + 78848); LAS bf16* UTs = (LAS bf16*)(C.lds + 97280); LAS bf16* VNT = (LAS bf16*)(C.lds + 115712); LAS float* OB = (LAS float*)(C.lds + 34816);
    const bf16* H = (const bf16*)(a.ws + WS_H); bf16* MIX = (bf16*)(a.ws + WS_MIX); const float* dng = (const float*)a.in[I_DNG];
    f32x16 S0 = {}, S1 = {};
    for (int x = tid; x < 128 * LDA / 2; x += NTHREADS) ((LAS unsigned*)STs)[x] = 0u;
    for (int n = 0; n < 32; ++n) {
        const unsigned char* ck = a.ws + WS_CHK + (size_t)(unit * 32 + n) * CHK_BYTES;
        for (int x = tid; x < 1024; x += NTHREADS) { const int rw = x >> 4, c8 = x & 15;
            *(LAS u32x4*)(NWs + rw * LDA + c8 * 8) = *(const u32x4*)(ck + CK_NW + x * 16);
            *(LAS u32x4*)(QGs + rw * LDA + c8 * 8) = *(const u32x4*)(ck + CK_QG + x * 16); }
        for (int x = tid; x < 1024; x += NTHREADS) { const int rw = x >> 3, c8 = x & 7;
            *(LAS u32x4*)(KDs + rw * LDT + c8 * 8) = *(const u32x4*)(ck + CK_KDT + x * 16);
            *(LAS u32x4*)(UTs + rw * LDT + c8 * 8) = *(const u32x4*)(ck + CK_UT + x * 16); }
        { const int x = tid, rw = x >> 3, c8 = x & 7; *(LAS u32x4*)(QKs + rw * LDT + c8 * 8) = *(const u32x4*)(ck + CK_QK + x * 16); }
        const float gl = *(const float*)(ck + CK_GL);
        __syncthreads();
        f32x16 vn, o = {};
#pragma unroll
        for (int g4 = 0; g4 < 4; ++g4) { const u32x2 x = *(const LAS u32x2*)(UTs + (32 * p + r) * LDT + 32 * hf + 8 * g4 + 4 * hh);
            vn[4 * g4] = bflo(x.x); vn[4 * g4 + 1] = bfhi(x.x); vn[4 * g4 + 2] = bflo(x.y); vn[4 * g4 + 3] = bfhi(x.y); }
        vn = mm_tile<128>(NWs + 32 * hf * LDA, LDA, STs + 32 * p * LDA, LDA, vn, lane);
        o = mm_tile<128>(QGs + 32 * hf * LDA, LDA, STs + 32 * p * LDA, LDA, o, lane);
#pragma unroll
        for (int g4 = 0; g4 < 4; ++g4) { u32x2 pk; pk.x = pk2(vn[4 * g4], vn[4 * g4 + 1]); pk.y = pk2(vn[4 * g4 + 2], vn[4 * g4 + 3]);
            *(LAS u32x2*)(VNT + (32 * p + r) * LDT + 32 * hf + 8 * g4 + 4 * hh) = pk; }
        __syncthreads();
        o = mm_tile<64>(QKs + 32 * hf * LDT, LDT, VNT + 32 * p * LDT, LDT, o, lane);
        S0 = S0 * gl; S1 = S1 * gl;
        S0 = mm_tile<64>(KDs + (64 * hf) * LDT, LDT, VNT + 32 * p * LDT, LDT, S0, lane);
        S1 = mm_tile<64>(KDs + (64 * hf + 32) * LDT, LDT, VNT + 32 * p * LDT, LDT, S1, lane);
#pragma unroll
        for (int reg = 0; reg < 16; ++reg) OB[(32 * hf + crow(reg, hh)) * 132 + 32 * p + r] = o[reg];
#pragma unroll
        for (int g4 = 0; g4 < 4; ++g4) { u32x2 pk; pk.x = pk2(S0[4 * g4], S0[4 * g4 + 1]); pk.y = pk2(S0[4 * g4 + 2], S0[4 * g4 + 3]);
            *(LAS u32x2*)(STs + (32 * p + r) * LDA + 64 * hf + 8 * g4 + 4 * hh) = pk;
            pk.x = pk2(S1[4 * g4], S1[4 * g4 + 1]); pk.y = pk2(S1[4 * g4 + 2], S1[4 * g4 + 3]);
            *(LAS u32x2*)(STs + (32 * p + r) * LDA + 64 * hf + 32 + 8 * g4 + 4 * hh) = pk; }
        __syncthreads();
        { const int i = tid >> 3, seg = tid & 7, row = b * SEQ + n * 64 + i; float v[16], ss = 0.f;
#pragma unroll
          for (int k = 0; k < 16; ++k) { v[k] = OB[i * 132 + seg * 16 + k]; ss += v[k] * v[k]; }
          ss += __shfl_xor(ss, 1); ss += __shfl_xor(ss, 2); ss += __shfl_xor(ss, 4);
          const float rs = rsqrtf(ss * (1.f / 128.f) + 1e-6f);
          const bf16* gp = H + (size_t)row * NE + CE_GATE + h * 128 + seg * 16; const u32x4 g0 = *(const u32x4*)gp, g1 = *(const u32x4*)(gp + 8);
          const unsigned gw[8] = {g0.x, g0.y, g0.z, g0.w, g1.x, g1.y, g1.z, g1.w}; unsigned ow[8];
#pragma unroll
          for (int k = 0; k < 8; ++k) { const float ga = bflo(gw[k]), gb = bfhi(gw[k]);
              ow[k] = pk2(v[2 * k] * rs * dng[seg * 16 + 2 * k] * siluf_(ga), v[2 * k + 1] * rs * dng[seg * 16 + 2 * k + 1] * siluf_(gb)); }
          bf16* op = MIX + (size_t)row * DM + h * 128 + seg * 16;
          *(u32x4*)op = (u32x4){ow[0], ow[1], ow[2], ow[3]}; *(u32x4*)(op + 8) = (u32x4){ow[4], ow[5], ow[6], ow[7]}; }
        __syncthreads();
    }
    float* So = a.out + O_DS_P + (size_t)unit * 128 * 128;
#pragma unroll
    for (int reg = 0; reg < 16; ++reg) { So[(size_t)(64 * hf + crow(reg, hh)) * 128 + 32 * p + r] = S0[reg]; So[(size_t)(64 * hf + 32 + crow(reg, hh)) * 128 + 32 * p + r] = S1[reg]; }
}

DI void delta_sample(const Args& a, const Ctx& C, int unit) {
    const int b = unit >> 2, h = unit & 3, tid = C.tid, lane = C.lane, wave = C.wave, row = MP + b;
    LAS float* raw = (LAS float*)C.lds;
    LAS float* part = raw + 384;
    LAS float* misc = part + 1024;
    const bf16* H = (const bf16*)(a.ws + WS_H); const float* HS = (const float*)(a.ws + WS_HS);
    const float* cst = (const float*)a.in[I_DCONV] + (size_t)b * 3 * 1536; const float* cw = (const float*)a.in[I_CONVW];
    if (tid < 384) { const int ch = (tid >> 7) * 512 + h * 128 + (tid & 127);
        float y = cst[ch] * cw[ch] + cst[1536 + ch] * cw[1536 + ch] + cst[3072 + ch] * cw[3072 + ch] + bf2f(H[(size_t)row * NE + ch]) * cw[4608 + ch];
        raw[tid] = siluf_(y);
        a.out[O_DCONV_S + ((size_t)b * 3 + 0) * 1536 + ch] = cst[1536 + ch]; a.out[O_DCONV_S + ((size_t)b * 3 + 1) * 1536 + ch] = cst[3072 + ch]; }
    __syncthreads();
    if (wave < 2) { const float x0 = raw[wave * 128 + lane], x1 = raw[wave * 128 + 64 + lane]; const float nrm = rsqrtf(wave_sum(x0 * x0 + x1 * x1) + 1e-6f) * (wave == 0 ? 0.08838834764831845f : 1.f);
        raw[wave * 128 + lane] = x0 * nrm; raw[wave * 128 + 64 + lane] = x1 * nrm; }
    __syncthreads();
    const float beta = sigmoidf_(HS[(size_t)row * 32 + h]);
    const float g = -__expf(((const float*)a.in[I_ALOG])[h]) * softplusf_(HS[(size_t)row * 32 + 4 + h] + ((const float*)a.in[I_DTB])[h]);
    const float eg = __expf(g);
    const float* S0 = (const float*)a.in[I_DS] + (size_t)unit * 128 * 128;
    const int e = tid & 127, pt = tid >> 7;
    { float ks = 0.f, qs = 0.f;
#pragma unroll 8
      for (int d = pt * 32; d < pt * 32 + 32; ++d) { const float s = S0[d * 128 + e]; ks += raw[128 + d] * s; qs += raw[d] * s; }
      part[pt * 128 + e] = ks; part[512 + pt * 128 + e] = qs; }
    if (wave == 2) { const float qk = wave_sum(raw[lane] * raw[128 + lane] + raw[64 + lane] * raw[192 + lane]); if (lane == 0) misc[256] = qk; }
    __syncthreads();
    if (tid < 128) { const float ks = (part[e] + part[128 + e]) + (part[256 + e] + part[384 + e]), qs = (part[512 + e] + part[640 + e]) + (part[768 + e] + part[896 + e]);
        const float vn = beta * (raw[256 + e] - eg * ks); misc[e] = vn; misc[128 + e] = eg * qs + misc[256] * vn; }
    __syncthreads();
    { float* So = a.out + O_DS_S + (size_t)unit * 128 * 128; const float vn = misc[e];
#pragma unroll 8
      for (int d = pt * 32; d < pt * 32 + 32; ++d) So[d * 128 + e] = S0[d * 128 + e] * eg + raw[128 + d] * vn; }
    if (wave == 0) { const float o0 = misc[128 + lane], o1 = misc[192 + lane]; const float rs = rsqrtf(wave_sum(o0 * o0 + o1 * o1) * (1.f / 128.f) + 1e-6f);
        const float* dng = (const float*)a.in[I_DNG]; const bf16* gp = H + (size_t)row * NE + CE_GATE + h * 128; bf16* op = (bf16*)(a.ws + WS_MIX) + (size_t)row * DM + h * 128;
        op[lane] = (bf16)f2bf(o0 * rs * dng[lane] * siluf_(bf2f(gp[lane]))); op[64 + lane] = (bf16)f2bf(o1 * rs * dng[64 + lane] * siluf_(bf2f(gp[64 + lane]))); }
    __syncthreads();
}
DI float kdot_bf16(const bf16* kp, const LAS float* qs) {
    float s = 0.f;
#pragma unroll
    for (int c = 0; c < 8; ++c) { const u32x4 x = *(const u32x4*)(kp + 8 * c); const f32x4 q0 = *(const LAS f32x4*)(qs + 8 * c), q1 = *(const LAS f32x4*)(qs + 8 * c + 4);
        s += bflo(x.x) * q0[0] + bfhi(x.x) * q0[1] + bflo(x.y) * q0[2] + bfhi(x.y) * q0[3] + bflo(x.z) * q1[0] + bfhi(x.z) * q1[1] + bflo(x.w) * q1[2] + bfhi(x.w) * q1[3]; }
    return s;
}
DI float kdot_f32(const float* kp, const LAS float* qs) {
    float s = 0.f;
#pragma unroll
    for (int c = 0; c < 16; ++c) { const f32x4 x = *(const f32x4*)(kp + 4 * c); const f32x4 q = *(const LAS f32x4*)(qs + 4 * c); s += x[0] * q[0] + x[1] * q[1] + x[2] * q[2] + x[3] * q[3]; }
    return s;
}
template <class VF> DI void att_block(float s, bool valid, int nkeys, float& m, float& l, float& o, VF vf) {
    const float bm = wave_max(valid ? s : -1e30f);
    if (bm <= -1e30f) return;
    const float mn = fmaxf(m, bm), alpha = __expf(m - mn), p = valid ? __expf(s - mn) : 0.f;
    l = l * alpha + wave_sum(p); o *= alpha; m = mn;
    for (int rr = 0; rr < nkeys; ++rr) o += __shfl(p, rr) * vf(rr);
}
template <bool SAMPLE> DI void nsa_naive(const Args& a, const Ctx& C, int b, int t) {
    constexpr int NC = SAMPLE ? 256 : 64, NS = SAMPLE ? 129 : 32;
    const int lane = C.lane, hd = C.wave, g = hd >> 2, row = SAMPLE ? MP + b : b * SEQ + t;
    LAS float* qs = (LAS float*)C.lds + hd * 64;
    LAS float* P = (LAS float*)C.lds + 512 + hd * 256;
    LAS float* SC = (LAS float*)C.lds + 512 + 2048;
    LAS int* SEL = (LAS int*)((LAS float*)C.lds + 512 + 2048 + 384);
    const bf16* H = (const bf16*)(a.ws + WS_H); const float* HS = (const float*)(a.ws + WS_HS);
    const bf16* Hr = H + (size_t)row * NE;
    const float* cache = (const float*)a.in[I_CACHE]; const int* pt = (const int*)a.in[I_PT] + b * NPAGE;
    qs[lane] = bf2f(Hr[CE_QB + hd * 64 + lane]) * 0.125f;
    LDS_WAIT();
    const float* kcb = SAMPLE ? (const float*)(a.ws + WS_KCBS) + (size_t)b * 256 * 256 : (const float*)(a.ws + WS_KCBP) + (size_t)b * 64 * 256;
    const int nvalid = SAMPLE ? 256 : (t + 1) / 32;
    float sc[NC / 64]; float mx = -1e30f;
#pragma unroll
    for (int j = 0; j < NC / 64; ++j) { const int c = lane + 64 * j; sc[j] = kdot_f32(kcb + (size_t)c * 256 + g * 64, qs); if (c < nvalid) mx = fmaxf(mx, sc[j]); }
    mx = wave_max(mx); float sum = 0.f;
#pragma unroll
    for (int j = 0; j < NC / 64; ++j) { const int c = lane + 64 * j; sc[j] = (c < nvalid) ? __expf(sc[j] - mx) : 0.f; sum += sc[j]; }
    sum = wave_sum(sum); const float inv = sum > 0.f ? 1.f / sum : 0.f;
#pragma unroll
    for (int j = 0; j < NC / 64; ++j) P[lane + 64 * j] = sc[j] * inv;
    LDS_WAIT();
    float o_cmp = 0.f;
    for (int c = 0; c < nvalid; ++c) o_cmp += P[c] * kcb[(size_t)c * 256 + 128 + g * 64 + lane];
    __syncthreads();
    if ((hd & 3) == 0) {
        const LAS float* Pg = (LAS float*)C.lds + 512 + g * 4 * 256; const int cur = t >> 6;
#pragma unroll
        for (int jj = 0; jj < (NS + 63) / 64; ++jj) { const int j = lane + 64 * jj;
            if (j < NS) { float imp = 0.f;
                if (2 * j + 1 < NC) { const float i0 = ((Pg[2 * j] + Pg[256 + 2 * j]) + Pg[512 + 2 * j]) + Pg[768 + 2 * j], i1 = ((Pg[2 * j + 1] + Pg[256 + 2 * j + 1]) + Pg[512 + 2 * j + 1]) + Pg[768 + 2 * j + 1]; imp = i0 + i1; }
                const bool forced = (j == 0) || (j == cur) || (j == cur - 1), valid = j * 64 <= t;
                SC[g * 192 + j] = forced ? 1e9f : (valid ? imp : -1e30f); } }
        LDS_WAIT();
#pragma unroll
        for (int jj = 0; jj < (NS + 63) / 64; ++jj) { const int j = lane + 64 * jj;
            if (j < NS) { const float sj = SC[g * 192 + j]; int rank = 0;
                for (int i = 0; i < NS; ++i) { const float si = SC[g * 192 + i]; rank += (si > sj || (si == sj && i < j)) ? 1 : 0; }
                SEL[g * 192 + j] = rank < 16 ? 1 : 0; } }
    }
    __syncthreads();
    float m_s = -1e30f, l_s = 0.f, o_s = 0.f;
    for (int j = 0; j < NS; ++j) {
        if (!SEL[g * 192 + j] || j * 64 > t) continue;
        const int kpos = j * 64 + lane; const bool valid = kpos <= t; const int nk = min(64, t - j * 64 + 1);
        if (SAMPLE) {
            if (j == 128) {
                const float s = wave_sum(qs[lane] * bf2f(Hr[CE_KV + 256 + g * 64 + lane]));
                const float vv = bf2f(Hr[CE_KV + 384 + g * 64 + lane]);
                const float mn = fmaxf(m_s, s), alpha = __expf(m_s - mn), p = __expf(s - mn); l_s = l_s * alpha + p; o_s = o_s * alpha + p * vv; m_s = mn;
            } else {
                const float* pg = cache + ((size_t)pt[j >> 1] * 128 + (j & 1) * 64) * 512;
                const float s = kdot_f32(pg + (size_t)lane * 512 + 256 + g * 64, qs);
                att_block(s, true, 64, m_s, l_s, o_s, [&](int rr) { return pg[(size_t)rr * 512 + 384 + g * 64 + lane]; });
            }
        } else {
            const bf16* kb = H + (size_t)(b * SEQ + j * 64) * NE + CE_KV + 256 + g * 64;
            const float s = valid ? kdot_bf16(kb + (size_t)lane * NE, qs) : 0.f;
            att_block(s, valid, nk, m_s, l_s, o_s, [&](int rr) { return bf2f(kb[(size_t)rr * NE + 128 + lane]); });
        }
    }
    float m_w = -1e30f, l_w = 0.f, o_w = 0.f;
    if (SAMPLE) {
        const float* wb = (const float*)a.in[I_WINST] + (size_t)b * 512 * 256;
        for (int c = 0; c < 8; ++c) { const int i = c * 64 + lane; const bool valid = i >= 1;
            const float s = kdot_f32(wb + (size_t)i * 256 + g * 64, qs);
            att_block(s, valid, 64, m_w, l_w, o_w, [&](int rr) { return wb[(size_t)(c * 64 + rr) * 256 + 128 + g * 64 + lane]; }); }
        { const float s = wave_sum(qs[lane] * bf2f(Hr[CE_KV + 512 + g * 64 + lane])); const float vv = bf2f(Hr[CE_KV + 640 + g * 64 + lane]);
          const float mn = fmaxf(m_w, s), alpha = __expf(m_w - mn), p = __expf(s - mn); l_w = l_w * alpha + p; o_w = o_w * alpha + p * vv; m_w = mn; }
    } else {
        const int k0 = max(0, t - 511);
        for (int kb0 = k0; kb0 <= t; kb0 += 64) { const int kpos = kb0 + lane; const bool valid = kpos <= t; const int nk = min(64, t - kb0 + 1);
            const bf16* kb = H + (size_t)(b * SEQ + kb0) * NE + CE_KV + 512 + g * 64;
            const float s = valid ? kdot_bf16(kb + (size_t)lane * NE, qs) : 0.f;
            att_block(s, valid, nk, m_w, l_w, o_w, [&](int rr) { return bf2f(kb[(size_t)rr * NE + 128 + lane]); }); }
    }
    const float* gp = HS + (size_t)row * 32 + 8 + hd * 3;
    const float o = sigmoidf_(gp[0]) * o_cmp + sigmoidf_(gp[1]) * (l_s > 0.f ? o_s / l_s : 0.f) + sigmoidf_(gp[2]) * (l_w > 0.f ? o_w / l_w : 0.f);
    ((bf16*)(a.ws + WS_MIX))[(size_t)row * DM + 512 + hd * 64 + lane] = (bf16)f2bf(o);
    __syncthreads();
}
DI void mix_even(const Args& a, const Ctx& C) {
    if (C.bid < 32) delta_scan(a, C, C.bid);
    for (int u = C.bid; u < 128; u += C.G) delta_sample(a, C, u);
    for (int u = C.bid; u < DB; u += C.G) {
        nsa_naive<true>(a, C, u, PAST);
        const float* wb = (const float*)a.in[I_WINST] + (size_t)u * 512 * 256; float* wo = a.out + O_WIN_S + (size_t)u * 512 * 256;
        for (int x = C.tid; x < 511 * 64; x += NTHREADS) *(f32x4*)(wo + (size_t)x * 4) = *(const f32x4*)(wb + 256 + (size_t)x * 4);
    }
    for (int u = C.bid; u < MP; u += C.G) nsa_naive<false>(a, C, u >> 11, u & (SEQ - 1));
}
DI void gla_chunk_prep(const Args& a, const Ctx& C, int unit) {
    const int b = unit >> 7, h = (unit >> 5) & 3, n = unit & 31, tid = C.tid, lane = C.lane, wave = C.wave, row0 = b * SEQ + n * 64;
    const bf16* H = (const bf16*)(a.ws + WS_H); const float* HS = (const float*)(a.ws + WS_HS);
    unsigned char* ck = a.ws + WS_CHK + (size_t)unit * CHK_BYTES;
    LAS bf16* QTs = (LAS bf16*)(C.lds); LAS bf16* KTs = (LAS bf16*)(C.lds + 17408); LAS bf16* KDs = (LAS bf16*)(C.lds + 34816);
    LAS float* G1 = (LAS float*)(C.lds + 53248);
    LAS float* PS = (LAS float*)(C.lds + 57344);
    for (int x = tid; x < 1024; x += NTHREADS) G1[x] = HS[(size_t)(row0 + (x >> 4)) * 32 + (x & 15)];
    const int d = tid & 127, part = tid >> 7;
    float w2[16]; const float* W2 = (const float*)a.in[I_WG2] + h * 128 + d;
#pragma unroll
    for (int j = 0; j < 16; ++j) w2[j] = W2[j * 512];
    const float b2 = ((const float*)a.in[I_BG2])[h * 128 + d];
    __syncthreads();
    float la[16], run = 0.f;
#pragma unroll
    for (int ii = 0; ii < 16; ++ii) { const int i = part * 16 + ii; float x = b2;
#pragma unroll
        for (int j = 0; j < 16; ++j) x += G1[i * 16 + j] * w2[j];
        run += logsigmoidf_(x) * (1.f / 16.f); la[ii] = run; }
    PS[part * 128 + d] = run;
    __syncthreads();
    float off = 0.f, tot = 0.f;
#pragma unroll
    for (int pp = 0; pp < 4; ++pp) { const float v = PS[pp * 128 + d]; if (pp < part) off += v; tot += v; }
#pragma unroll
    for (int ii = 0; ii < 16; ++ii) { const int i = part * 16 + ii; const float bc = la[ii] + off; const bf16* hr = H + (size_t)(row0 + i) * NO + h * 128 + d;
        const float q = bf2f(hr[CO_Q]) * 0.08838834764831845f, k = bf2f(hr[CO_K]);
        const bf16 qt = (bf16)f2bf(q * __expf(bc));
        QTs[i * LDA + d] = qt; *(bf16*)(ck + GK_QT + (i * 128 + d) * 2) = qt;
        KTs[i * LDA + d] = (bf16)f2bf(k * __expf(-bc));
        KDs[d * LDT + i] = (bf16)f2bf(k * __expf(tot - bc)); }
    if (part == 0) *(float*)(ck + GK_GL + d * 4) = __expf(tot);
    __syncthreads();
    for (int x = tid; x < 128 * 8; x += NTHREADS) { const int dd = x >> 3, c8 = x & 7; *(u32x4*)(ck + GK_KDT + (dd * 64 + c8 * 8) * 2) = *(const LAS u32x4*)(KDs + dd * LDT + c8 * 8); }
    if (wave < 4) { const int ti = wave >> 1, tj = wave & 1, r = lane & 31, hh = lane >> 5; f32x16 acc = {};
        acc = mm_tile<128>(QTs + ti * 32 * LDA, LDA, KTs + tj * 32 * LDA, LDA, acc, lane);
        const int j = tj * 32 + r;
#pragma unroll
        for (int reg = 0; reg < 16; ++reg) { const int i = ti * 32 + crow(reg, hh); *(bf16*)(ck + GK_ATT + (i * 64 + j) * 2) = (bf16)f2bf(i >= j ? acc[reg] : 0.f); } }
    __syncthreads();
}
DI void prep_odd(const Args& a, const Ctx& C) { for (int u = C.bid; u < 1024; u += C.G) gla_chunk_prep(a, C, u); }

DI void gla_scan(const Args& a, const Ctx& C, int unit) {
    const int bh = unit >> 2, es = unit & 3, b = bh >> 2, h = bh & 3, tid = C.tid, lane = C.lane, wave = C.wave, r = lane & 31, hh = lane >> 5, dt = wave >> 1, et = wave & 1;
    LAS bf16* STs = (LAS bf16*)(C.lds); LAS bf16* QTs = (LAS bf16*)(C.lds + 17408); LAS bf16* ATs = (LAS bf16*)(C.lds + 34816); LAS bf16* VT = (LAS bf16*)(C.lds + 44032); LAS bf16* KDs = (LAS bf16*)(C.lds + 53248);
    LAS float* GL = (LAS float*)(C.lds + 71680);
    const bf16* H = (const bf16*)(a.ws + WS_H); float* OG = (float*)(a.ws + WS_Y);
    f32x16 S = {};
    for (int x = tid; x < 64 * LDA / 2; x += NTHREADS) ((LAS unsigned*)STs)[x] = 0u;
    for (int n = 0; n < 32; ++n) {
        const unsigned char* ck = a.ws + WS_CHK + (size_t)(bh * 32 + n) * CHK_BYTES; const int row0 = b * SEQ + n * 64;
        for (int x = tid; x < 1024; x += NTHREADS) { const int rw = x >> 4, c8 = x & 15; *(LAS u32x4*)(QTs + rw * LDA + c8 * 8) = *(const u32x4*)(ck + GK_QT + x * 16); }
        for (int x = tid; x < 1024; x += NTHREADS) { const int rw = x >> 3, c8 = x & 7; *(LAS u32x4*)(KDs + rw * LDT + c8 * 8) = *(const u32x4*)(ck + GK_KDT + x * 16); }
        { const int x = tid, rw = x >> 3, c8 = x & 7; *(LAS u32x4*)(ATs + rw * LDT + c8 * 8) = *(const u32x4*)(ck + GK_ATT + x * 16); }
        { const int s = tid >> 3, c8 = tid & 7; const u32x4 x = *(const u32x4*)(H + (size_t)(row0 + s) * NO + CO_V + h * 256 + es * 64 + c8 * 8); const unsigned w[4] = {x.x, x.y, x.z, x.w};
#pragma unroll
          for (int k = 0; k < 4; ++k) { VT[(c8 * 8 + 2 * k) * LDT + s] = (bf16)(w[k] & 0xffffu); VT[(c8 * 8 + 2 * k + 1) * LDT + s] = (bf16)(w[k] >> 16); } }
        if (tid < 128) GL[tid] = *(const float*)(ck + GK_GL + tid * 4);
        __syncthreads();
        if (wave < 4) {
            f32x16 o = {};
            o = mm_tile<128>(QTs + 32 * dt * LDA, LDA, STs + 32 * et * LDA, LDA, o, lane);
            o = mm_tile<64>(ATs + 32 * dt * LDT, LDT, VT + 32 * et * LDT, LDT, o, lane);
#pragma unroll
            for (int reg = 0; reg < 16; ++reg) OG[(size_t)(row0 + 32 * dt + crow(reg, hh)) * DM + h * 256 + es * 64 + 32 * et + r] = o[reg];
        }
        __syncthreads();
#pragma unroll
        for (int reg = 0; reg < 16; ++reg) S[reg] *= GL[32 * dt + crow(reg, hh)];
        S = mm_tile<64>(KDs + 32 * dt * LDT, LDT, VT + 32 * et * LDT, LDT, S, lane);
#pragma unroll
        for (int g4 = 0; g4 < 4; ++g4) { u32x2 pk; pk.x = pk2(S[4 * g4], S[4 * g4 + 1]); pk.y = pk2(S[4 * g4 + 2], S[4 * g4 + 3]);
            *(LAS u32x2*)(STs + (32 * et + r) * LDA + 32 * dt + 8 * g4 + 4 * hh) = pk; }
        __syncthreads();
    }
    float* So = a.out + O_GS_P + (size_t)bh * 128 * 256;
#pragma unroll
    for (int reg = 0; reg < 16; ++reg) So[(size_t)(32 * dt + crow(reg, hh)) * 256 + es * 64 + 32 * et + r] = S[reg];
}
DI void gla_sample(const Args& a, const Ctx& C, int unit) {
    const int b = unit >> 2, h = unit & 3, tid = C.tid, lane = C.lane, wave = C.wave, row = MP + b;
    LAS float* qa = (LAS float*)C.lds;
    LAS float* kk = qa + 128; LAS float* aa = qa + 256; LAS float* vv = qa + 384; LAS float* oo = qa + 640; LAS float* part = qa + 896; LAS float* scal = qa + 1408;
    const bf16* Hr = (const bf16*)(a.ws + WS_H) + (size_t)row * NO; const float* g1 = (const float*)(a.ws + WS_HS) + (size_t)row * 32;
    if (tid < 128) { const int d = tid; float x = ((const float*)a.in[I_BG2])[h * 128 + d]; const float* W2 = (const float*)a.in[I_WG2] + h * 128 + d;
#pragma unroll
        for (int j = 0; j < 16; ++j) x += g1[j] * W2[j * 512];
        const float av = __expf(logsigmoidf_(x) * (1.f / 16.f)); const float q = bf2f(Hr[CO_Q + h * 128 + d]) * 0.08838834764831845f, k = bf2f(Hr[CO_K + h * 128 + d]);
        qa[d] = q * av; kk[d] = k; aa[d] = av; part[d] = q * k; }
    else if (tid < 384) vv[tid - 128] = bf2f(Hr[CO_V + h * 256 + tid - 128]);
    __syncthreads();
    if (wave == 0) { const float s = wave_sum(part[lane] + part[64 + lane]); if (lane == 0) scal[0] = s; }
    __syncthreads();
    const float qk = scal[0]; const float* S0 = (const float*)a.in[I_GS] + (size_t)unit * 128 * 256; float* So = a.out + O_GS_S + (size_t)unit * 128 * 256;
    const int e = tid & 255, pt = tid >> 8; float acc = 0.f; const float ve = vv[e];
#pragma unroll 8
    for (int d = pt * 64; d < pt * 64 + 64; ++d) { const float s = S0[d * 256 + e]; acc += qa[d] * s; So[d * 256 + e] = aa[d] * s + kk[d] * ve; }
    __syncthreads();
    part[pt * 256 + e] = acc;
    __syncthreads();
    if (tid < 256) oo[e] = part[e] + part[256 + e] + qk * ve;
    __syncthreads();
    if (wave == 0) { float ss = 0.f;
#pragma unroll
        for (int k = 0; k < 4; ++k) ss += oo[lane + 64 * k] * oo[lane + 64 * k];
        const float rs = rsqrtf(wave_sum(ss) * (1.f / 256.f) + 1e-6f); const float* gng = (const float*)a.in[I_GNG]; bf16* op = (bf16*)(a.ws + WS_MIX) + (size_t)row * DM + h * 256;
#pragma unroll
        for (int k = 0; k < 4; ++k) { const int ee = lane + 64 * k; op[ee] = (bf16)f2bf(oo[ee] * rs * gng[ee] * siluf_(bf2f(Hr[CO_R + h * 256 + ee]))); } }
    __syncthreads();
}
DI void mix_odd(const Args& a, const Ctx& C) {
    for (int u = C.bid; u < 128; u += C.G) gla_scan(a, C, u);
    for (int u = C.G - 1 - C.bid; u < 128; u += C.G) gla_sample(a, C, u);
}
DI void gla_norm(const Args& a, const Ctx& C) {
    const int gw = C.bid * NWAVES + C.wave, NGW = C.G * NWAVES, lane = C.lane;
    const float* OG = (const float*)(a.ws + WS_Y); const bf16* H = (const bf16*)(a.ws + WS_H); bf16* MIX = (bf16*)(a.ws + WS_MIX); const float* gng = (const float*)a.in[I_GNG];
    const f32x4 gv = *(const f32x4*)(gng + 4 * lane);
    for (int it = gw; it < MP * 4; it += NGW) { const int row = it >> 2, h = it & 3;
        const f32x4 o = *(const f32x4*)(OG + (size_t)row * DM + h * 256 + 4 * lane);
        const float rs = rsqrtf(wave_sum(o[0] * o[0] + o[1] * o[1] + o[2] * o[2] + o[3] * o[3]) * (1.f / 256.f) + 1e-6f);
        const u32x2 rr = *(const u32x2*)(H + (size_t)row * NO + CO_R + h * 256 + 4 * lane);
        u32x2 w; w.x = pk2(o[0] * rs * gv[0] * siluf_(bflo(rr.x)), o[1] * rs * gv[1] * siluf_(bfhi(rr.x))); w.y = pk2(o[2] * rs * gv[2] * siluf_(bflo(rr.y)), o[3] * rs * gv[3] * siluf_(bfhi(rr.y)));
        *(u32x2*)(MIX + (size_t)row * DM + h * 256 + 4 * lane) = w; }
}
template <class Epi> DI void run_gemm(const Ctx& C, const bf16* A, const bf16* Bt, int N, int K, const Epi& E) {
    pg8::Gemm g{A, Bt, MT, N, K}; pg8::StaticOrder S; S.init(MT, N, C.G, C.bid);
    pg8::gemm_phase<Epi, pg8::StaticOrder, true, true>(C.lds, g, S, E);
}
constexpr int NPH = 18;
__global__ void __launch_bounds__(NTHREADS, 2) mk(Args a) {
    extern __shared__ __attribute__((aligned(16))) unsigned char lds_raw[];
    Ctx C; C.lds = (LAS unsigned char*)lds_raw; C.tid = threadIdx.x; C.lane = C.tid & 63; C.wave = __builtin_amdgcn_readfirstlane(C.tid >> 6); C.G = gridDim.x; C.bid = blockIdx.x;
    cg::grid_group grid = cg::this_grid();
#define PH(k) if (a.ph_lo <= (k) && (k) < a.ph_hi)
#define SEAM(k) do { if (a.ph_lo <= (k) && (k) + 1 < a.ph_hi) { __syncthreads(); grid.sync(); } } while (0)
#define WSP(T, off) ((T*)(a.ws + (off)))
    PH(0) p0_prologue(a, C);
    SEAM(0);
    PH(1) { pg8::EpiInE E{WSP(bf16, WS_H), WSP(float, WS_HS), a.out}; run_gemm(C, WSP(const bf16, WS_XB), WSP(const bf16, WS_WINE), NE, DM, E); }
    SEAM(1);
    PH(2) prep_even(a, C);
    SEAM(2);
    PH(3) mix_even(a, C);
    SEAM(3);
    PH(4) { pg8::EpiF32 E{WSP(float, WS_Y)}; run_gemm(C, WSP(const bf16, WS_MIX), WSP(const bf16, WS_WOE), DM, DM, E); }
    SEAM(4);
    PH(5) ln_phase(a, C, 0, 0);
    SEAM(5);
    PH(6) { pg8::EpiGU E{WSP(bf16, WS_FF)}; run_gemm(C, WSP(const bf16, WS_XB), WSP(const bf16, WS_WGU), NGU, DM, E); }
    SEAM(6);
    PH(7) { pg8::EpiF32 E{WSP(float, WS_Y)}; run_gemm(C, WSP(const bf16, WS_FF), WSP(const bf16, WS_WD), DM, DFF, E); }
    SEAM(7);
    PH(8) ln_phase(a, C, 0, 1);
    SEAM(8);
    PH(9) { pg8::EpiInO E{WSP(bf16, WS_H), WSP(float, WS_HS)}; run_gemm(C, WSP(const bf16, WS_XB), WSP(const bf16, WS_WINO), NO, DM, E); }
    SEAM(9);
    PH(10) prep_odd(a, C);
    SEAM(10);
    PH(11) mix_odd(a, C);
    SEAM(11);
    PH(12) gla_norm(a, C);
    SEAM(12);
    PH(13) { pg8::EpiF32 E{WSP(float, WS_Y)}; run_gemm(C, WSP(const bf16, WS_MIX), WSP(const bf16, WS_WOO), DM, DM, E); }
    SEAM(13);
    PH(14) ln_phase(a, C, 1, 0);
    SEAM(14);
    PH(15) { pg8::EpiGU E{WSP(bf16, WS_FF)}; run_gemm(C, WSP(const bf16, WS_XB), WSP(const bf16, WS_WGU + al((size_t)NGU * DM * 2)), NGU, DM, E); }
    SEAM(15);
    PH(16) { pg8::EpiF32 E{WSP(float, WS_Y)}; run_gemm(C, WSP(const bf16, WS_FF), WSP(const bf16, WS_WD + al((size_t)DM * DFF * 2)), DM, DFF, E); }
    SEAM(16);
    PH(17) ln_phase(a, C, 1, 1);
}

#ifndef MK_N_LAUNCHES
#define MK_N_LAUNCHES 1
#endif
extern "C" void kernel_launch(void* const* d_in, const int* in_sizes, int n_in, void* d_out, int out_size, void* d_ws, size_t ws_size, hipStream_t stream) {
    static int grid = 0;
    if (grid == 0) {
        if (n_in != N_IN || out_size != (int)O_END || ws_size < WS_END) { fprintf(stderr, "kernel_launch: unexpected shapes n_in %d out %d ws %zu (need %zu)\n", n_in, out_size, ws_size, (size_t)WS_END); grid = -1; return; }
        int dev = 0, cus = 0, per_cu = 0;
        hipGetDevice(&dev); hipDeviceGetAttribute(&cus, hipDeviceAttributeMultiprocessorCount, dev);
        if (hipFuncSetAttribute((const void*)mk, hipFuncAttributeMaxDynamicSharedMemorySize, LDS_BYTES) != hipSuccess) { fprintf(stderr, "kernel_launch: hipFuncSetAttribute failed\n"); grid = -1; return; }
        hipOccupancyMaxActiveBlocksPerMultiprocessor(&per_cu, (const void*)mk, NTHREADS, LDS_BYTES);
        (void)hipGetLastError();
        if (per_cu < 1) { fprintf(stderr, "kernel_launch: occupancy query says %d blocks/CU\n", per_cu); grid = -1; return; }
        grid = cus;
    }
    if (grid < 0) return;
    Args a{};
    for (int i = 0; i < N_IN; ++i) a.in[i] = d_in[i];
    a.out = (float*)d_out; a.ws = (unsigned char*)d_ws;
    if (MK_N_LAUNCHES == 1) {
        a.ph_lo = 0; a.ph_hi = NPH; void* args[] = {&a};
        hipError_t e = hipLaunchCooperativeKernel((const void*)mk, dim3(grid), dim3(NTHREADS), args, LDS_BYTES, stream);
        if (e != hipSuccess) fprintf(stderr, "cooperative launch failed: %s (grid %d)\n", hipGetErrorString(e), grid);
    } else {
        for (int p = 0; p < NPH; ++p) { a.ph_lo = p; a.ph_hi = p + 1; void* args[] = {&a};
            hipError_t e = hipLaunchCooperativeKernel((const void*)mk, dim3(grid), dim3(NTHREADS), args, LDS_BYTES, stream);
            if (e != hipSuccess) { fprintf(stderr, "launch %d failed: %s\n", p, hipGetErrorString(e)); break; } }
    }
}
```

```cpp
#include <hip/hip_runtime.h>
#include <hip/hip_cooperative_groups.h>
#include <cstdio>
#include <cstdint>
namespace cg = cooperative_groups;

#define LAS __attribute__((address_space(3)))
#define GAS __attribute__((address_space(1)))
#define DI __device__ __forceinline__
typedef unsigned short bf16;
typedef short bf16x8 __attribute__((ext_vector_type(8)));
typedef short s16x4 __attribute__((ext_vector_type(4)));
typedef float f32x4 __attribute__((ext_vector_type(4)));
typedef float f32x2 __attribute__((ext_vector_type(2)));
typedef float f32x16 __attribute__((ext_vector_type(16)));
typedef unsigned u32x4 __attribute__((ext_vector_type(4)));
typedef unsigned u32x2 __attribute__((ext_vector_type(2)));

constexpr int DM = 1024, NB = 8, SEQ = 2048, MP = NB * SEQ, DB = 32, MT = 16640  ;
constexpr int NE = 3584, NO = 3328, DFF = 2816, NGU = 5632;
constexpr int PAST = 8192, NPAGE = 64;
constexpr float ALPHA = 1.41421356237f;
constexpr int CE_QKV = 0, CE_GATE = 1536, CE_QB = 2048, CE_KV = 2560, CE_SMALL = 3328;
constexpr int CO_Q = 0, CO_K = 512, CO_V = 1024, CO_R = 2048, CO_G1 = 3072;

enum { I_XP = 0, I_XS, I_CACHE, I_WINST, I_DCONV, I_DS, I_GS, I_PT, I_WINE, I_CONVW, I_ALOG, I_DTB, I_DNG, I_WOE, I_WINO, I_WG2, I_BG2, I_GNG, I_WOO, I_FG, I_FU, I_FD, I_LNG, I_LNB, N_IN };

constexpr size_t O_YP = 0, O_YS = O_YP + (size_t)MP * DM, O_ROWS_P = O_YS + (size_t)DB * DM, O_WIN_P = O_ROWS_P + (size_t)MP * 512,
    O_DCONV_P = O_WIN_P + (size_t)NB * 512 * 256, O_DS_P = O_DCONV_P + (size_t)NB * 3 * 1536, O_GS_P = O_DS_P + (size_t)NB * 4 * 128 * 128,
    O_ROWS_S = O_GS_P + (size_t)NB * 4 * 128 * 256, O_WIN_S = O_ROWS_S + (size_t)DB * 512, O_DCONV_S = O_WIN_S + (size_t)DB * 512 * 256,
    O_DS_S = O_DCONV_S + (size_t)DB * 3 * 1536, O_GS_S = O_DS_S + (size_t)DB * 4 * 128 * 128, O_END = O_GS_S + (size_t)DB * 4 * 128 * 256;
static_assert(O_END == 38506496, "output size");

constexpr size_t MiB = 1u << 20;
constexpr size_t al(size_t x) { return (x + MiB - 1) & ~(MiB - 1); }
constexpr size_t WS_CTL = 0, CTL_BYTES = MiB;
constexpr size_t WS_WINE = WS_CTL + CTL_BYTES;
constexpr size_t WS_WOE = WS_WINE + al((size_t)NE * DM * 2);
constexpr size_t WS_WINO = WS_WOE + al((size_t)DM * DM * 2);
constexpr size_t WS_WOO = WS_WINO + al((size_t)NO * DM * 2);
constexpr size_t WS_WGU = WS_WOO + al((size_t)DM * DM * 2);
constexpr size_t WS_WD = WS_WGU + 2 * al((size_t)NGU * DM * 2);
constexpr size_t WS_XB = WS_WD + 2 * al((size_t)DM * DFF * 2);
constexpr size_t WS_H = WS_XB + al((size_t)MT * DM * 2);
constexpr size_t WS_HS = WS_H + al((size_t)MT * NE * 2);
constexpr size_t WS_MIX = WS_HS + al((size_t)MT * 32 * 4);
constexpr size_t WS_Y = WS_MIX + al((size_t)MT * DM * 2);
constexpr size_t WS_X1 = WS_Y + al((size_t)MT * DM * 4);
constexpr size_t WS_FF = WS_X1 + al((size_t)MT * DM * 4);
constexpr size_t WS_KCBP = WS_FF + al((size_t)MT * DFF * 2);
constexpr size_t WS_KCBS = WS_KCBP + al((size_t)NB * 64 * 256 * 4);
constexpr size_t WS_CHK = WS_KCBS + al((size_t)DB * 256 * 256 * 4);
constexpr size_t CHK_BYTES = 81920;
constexpr size_t WS_KCB = WS_CHK + al((size_t)1024 * CHK_BYTES);
constexpr size_t WS_VCBT = WS_KCB + al((size_t)NB * 2 * 64 * 64 * 2);
constexpr size_t WS_VTS = WS_VCBT + al((size_t)NB * 2 * 64 * 64 * 2);
constexpr size_t WS_VTW = WS_VTS + al((size_t)NB * 2 * 64 * SEQ * 2);
constexpr size_t WS_END = WS_VTW + al((size_t)NB * 2 * 64 * SEQ * 2);
constexpr int CTL_QUEUE = 64;

constexpr int NTHREADS = 512, NWAVES = 8;
constexpr int LDS_BYTES = 147456;

DI unsigned f2bf(float f) { unsigned u = __builtin_bit_cast(unsigned, f); return (u + 0x7fffu + ((u >> 16) & 1u)) >> 16; }
typedef __bf16 bf16x2_t __attribute__((ext_vector_type(2)));
DI unsigned pk2(float lo, float hi) { f32x2 v = {lo, hi}; bf16x2_t b = __builtin_convertvector(v, bf16x2_t); return __builtin_bit_cast(unsigned, b); }
DI float bf2f(bf16 v) { return __builtin_bit_cast(float, (unsigned)v << 16); }
DI float bflo(unsigned w) { return __builtin_bit_cast(float, w << 16); }
DI float bfhi(unsigned w) { return __builtin_bit_cast(float, w & 0xffff0000u); }
DI float sigmoidf_(float x) { return 1.f / (1.f + __expf(-x)); }
DI float siluf_(float x) { return x / (1.f + __expf(-x)); }
DI float wave_sum(float v) {
#pragma unroll
    for (int o = 1; o < 64; o <<= 1) v += __shfl_xor(v, o);
    return v; }
DI float wave_max(float v) {
#pragma unroll
    for (int o = 1; o < 64; o <<= 1) v = fmaxf(v, __shfl_xor(v, o));
    return v; }
#define LDS_WAIT() asm volatile("s_waitcnt lgkmcnt(0)" ::: "memory")
#define VM_WAIT() asm volatile("s_waitcnt vmcnt(0)" ::: "memory")
namespace pg8 {
#define PG8_LAS __attribute__((address_space(3)))
typedef unsigned short bf16_t;
typedef short bf16x8 __attribute__((ext_vector_type(8)));
typedef float f32x4 __attribute__((ext_vector_type(4)));
typedef unsigned u32x4 __attribute__((ext_vector_type(4)));
constexpr int BM = 256, BK = 64, HALF = 128, HTB = HALF * BK * 2  , STAGE_BYTES = 8 * HTB, NXCD = 8, WGM = 8;

__host__ __device__ __forceinline__ int lds_byte(int r, int c) { const int st = (r >> 4) * 2 + (c >> 5), rr = r & 15, cc = c & 31, ob = rr * 64 + cc * 2; return st * 1024 + (ob ^ (((ob >> 9) & 1) << 5)); }
__host__ __device__ __forceinline__ void stage_rc(int b, int& R, int& C) { const int st = b / 1024, sb = b % 1024, swz = sb ^ (((sb >> 9) & 1) << 5); R = (st >> 1) * 16 + swz / 64; C = (st & 1) * 32 + (swz % 64) / 2; }
__host__ __device__ __forceinline__ int perm32(int rho) { const int n = rho >> 4, i = rho & 15; return 8 * (i >> 2) + 4 * n + (i & 3); }

struct Unit { int pm, pn; };
struct Gemm { const bf16_t* A; const bf16_t* Bt; int M, N, K; };

struct StaticOrder {
    int nM, nN, nwg, G, c;
    __host__ __device__ void init(int M, int N, int G_, int c_) { nM = M / BM; nN = N / BM; nwg = nM * nN; G = G_; c = c_; }
    __host__ __device__ bool next(int i, Unit& u) const {
        const long L = (long)i * G + c; if (L >= nwg) return false;
        int wgid = (int)L; { const int q = nwg / NXCD, r = nwg % NXCD, xcd = wgid % NXCD, off = wgid / NXCD; wgid = (xcd < r ? xcd * (q + 1) : r * (q + 1) + (xcd - r) * q) + off; }
        const int nig = WGM * nN, gid = wgid / nig, fm = gid * WGM, gsz = (nM - fm) < WGM ? (nM - fm) : WGM;
        u.pm = fm + ((wgid % nig) % gsz); u.pn = (wgid % nig) / gsz; return true;
    }
    __device__ __forceinline__ void a_ready(const Unit&) const {}
    __device__ __forceinline__ void done(const Unit&) const {}
};
__device__ __forceinline__ unsigned cvt_pk_bf16(float lo, float hi) { unsigned r; asm volatile("v_cvt_pk_bf16_f32 %0, %1, %2" : "=v"(r) : "v"(lo), "v"(hi)); return r; }
__device__ __forceinline__ u32x4 pack8(f32x4 v0, f32x4 v1) { u32x4 w; w.x = cvt_pk_bf16(v0[0], v0[1]); w.y = cvt_pk_bf16(v0[2], v0[3]); w.z = cvt_pk_bf16(v1[0], v1[1]); w.w = cvt_pk_bf16(v1[2], v1[3]); return w; }

struct EpiInE {
    static constexpr bool PERM = true, AFTER_DRAIN = false;
    bf16_t* H; float* HS; float* out;
    __device__ __forceinline__ void operator()(const f32x4 (&acc)[2][2][4][2], const Unit& u, int wr, int wc, int fr, int fq) const {
        const int row0 = u.pm * BM + wr * 64 + fr, col0 = u.pn * BM + wc * 32 + 8 * fq, pn = u.pn;
#pragma unroll
        for (int ai = 0; ai < 2; ++ai)
#pragma unroll
            for (int m = 0; m < 4; ++m) { const int r = row0 + ai * HALF + m * 16;
#pragma unroll
                for (int bj = 0; bj < 2; ++bj) { const int c = col0 + bj * HALF; const f32x4 v0 = acc[ai][bj][m][0], v1 = acc[ai][bj][m][1];
                    *(u32x4*)(H + (size_t)r * NE + c) = pack8(v0, v1);
                    float* dst = nullptr;
                    if (pn < 6) { if (r < MP) { const int t = r & (SEQ - 1); if (t >= SEQ - 3) dst = out + O_DCONV_P + ((size_t)(r >> 11) * 3 + (t - (SEQ - 3))) * 1536 + c; }
                                  else if (r < MP + DB) dst = out + O_DCONV_S + ((size_t)(r - MP) * 3 + 2) * 1536 + c; }
                    else if (pn == 10 || pn == 11) { const int cc = c - CE_KV; if (r < MP) dst = out + O_ROWS_P + (size_t)r * 512 + cc; else if (r < MP + DB) dst = out + O_ROWS_S + (size_t)(r - MP) * 512 + cc; }
                    else if (pn == 12) { const int cc = c - (CE_KV + 512); if (r < MP) { const int t = r & (SEQ - 1); if (t >= SEQ - 512) dst = out + O_WIN_P + ((size_t)(r >> 11) * 512 + (t - (SEQ - 512))) * 256 + cc; }
                                         else if (r < MP + DB) dst = out + O_WIN_S + ((size_t)(r - MP) * 512 + 511) * 256 + cc; }
                    else if (pn == 13) { const int cc = c - CE_SMALL; if (cc < 32 && r < MP + DB) dst = HS + (size_t)r * 32 + cc; }
                    if (dst) { *(f32x4*)dst = v0; *(f32x4*)(dst + 4) = v1; } } }
    }
};
struct EpiInO {
    static constexpr bool PERM = true, AFTER_DRAIN = false;
    bf16_t* H; float* HS;
    __device__ __forceinline__ void operator()(const f32x4 (&acc)[2][2][4][2], const Unit& u, int wr, int wc, int fr, int fq) const {
        const int row0 = u.pm * BM + wr * 64 + fr, col0 = u.pn * BM + wc * 32 + 8 * fq, pn = u.pn;
#pragma unroll
        for (int ai = 0; ai < 2; ++ai)
#pragma unroll
            for (int m = 0; m < 4; ++m) { const int r = row0 + ai * HALF + m * 16;
#pragma unroll
                for (int bj = 0; bj < 2; ++bj) { const int c = col0 + bj * HALF; const f32x4 v0 = acc[ai][bj][m][0], v1 = acc[ai][bj][m][1];
                    *(u32x4*)(H + (size_t)r * NO + c) = pack8(v0, v1);
                    if (pn == 12) { const int cc = c - CO_G1; if (cc < 16 && r < MP + DB) { float* dst = HS + (size_t)r * 32 + cc; *(f32x4*)dst = v0; *(f32x4*)(dst + 4) = v1; } } } }
    }
};
struct EpiF32 {
    static constexpr bool PERM = false, AFTER_DRAIN = false;
    float* Y;
    __device__ __forceinline__ void operator()(const f32x4 (&acc)[2][2][4][2], const Unit& u, int wr, int wc, int fr, int fq) const {
        const int row0 = u.pm * BM + wr * 64 + fr, col0 = u.pn * BM + wc * 32 + 4 * fq;
#pragma unroll
        for (int ai = 0; ai < 2; ++ai)
#pragma unroll
            for (int m = 0; m < 4; ++m) { float* rowp = Y + (size_t)(row0 + ai * HALF + m * 16) * DM + col0;
#pragma unroll
                for (int bj = 0; bj < 2; ++bj)
#pragma unroll
                    for (int n = 0; n < 2; ++n) *(f32x4*)(rowp + bj * HALF + n * 16) = acc[ai][bj][m][n]; }
    }
};
struct EpiGU {
    static constexpr bool PERM = true, AFTER_DRAIN = false;
    bf16_t* FF;
    __device__ __forceinline__ void operator()(const f32x4 (&acc)[2][2][4][2], const Unit& u, int wr, int wc, int fr, int fq) const {
        const int row0 = u.pm * BM + wr * 64 + fr, col0 = u.pn * HALF + wc * 32 + 8 * fq;
#pragma unroll
        for (int ai = 0; ai < 2; ++ai)
#pragma unroll
            for (int m = 0; m < 4; ++m) { f32x4 o[2];
#pragma unroll
                for (int n = 0; n < 2; ++n) { const f32x4 g = acc[ai][0][m][n], up = acc[ai][1][m][n];
#pragma unroll
                    for (int i = 0; i < 4; ++i) o[n][i] = g[i] / (1.f + __expf(-g[i])) * up[i]; }
                *(u32x4*)(FF + (size_t)(row0 + ai * HALF + m * 16) * DFF + col0) = pack8(o[0], o[1]); }
    }
};
template <class Epi, class Sched, bool ALIGN_EPI = false, bool SP2 = false>
__device__ __forceinline__ void gemm_phase(PG8_LAS unsigned char* lds, const Gemm g, const Sched& S, const Epi& E) {
    const int tid = threadIdx.x, wid = __builtin_amdgcn_readfirstlane(tid >> 6), lane = tid & 63, wr = wid >> 2, wc = wid & 3, fr = lane & 15, fq = lane >> 4;
    const int K = g.K, nt = K / BK;
    unsigned voffA[2], voffB[2];
#pragma unroll
    for (int i = 0; i < 2; ++i) { int R, C; stage_rc(tid * 16 + i * 8192, R, C); const int Rb = Epi::PERM ? ((R & ~31) + perm32(R & 31)) : R;
        voffA[i] = (unsigned)(R * K + C) * 2u; voffB[i] = (unsigned)(Rb * K + C) * 2u; }
    const size_t kstep = (size_t)(BK * 2);
    const size_t hstep = (size_t)HALF * K * 2;
    const size_t tstep = 2 * hstep;
    const unsigned ldsw = (unsigned)wid * 1024u;
    const int aoff = lds_byte(wr * 64 + fr, fq * 8), boff = lds_byte(wc * 32 + fr, fq * 8);
#define PG8_SA(b, h) (((b) * 2 + (h)) * HTB)
#define PG8_SB(b, h) ((4 + (b) * 2 + (h)) * HTB)
#define PG8_STAGE(bufoff, gbase, voff) do { _Pragma("unroll") for (int _i = 0; _i < 2; ++_i) \
        __builtin_amdgcn_global_load_lds((const unsigned*)((const char*)(gbase) + (voff)[_i]), (PG8_LAS unsigned*)(lds + (bufoff) + ldsw + _i * 8192), 16, 0, 0); } while (0)
#define PG8_LDA(dst, b, h) do { _Pragma("unroll") for (int m = 0; m < 4; ++m) _Pragma("unroll") for (int k = 0; k < 2; ++k) dst[m][k] = *(const PG8_LAS bf16x8*)(lds + PG8_SA(b, h) + aoff + m * 2048 + k * 1024); } while (0)
#define PG8_LDB(dst, b, h) do { _Pragma("unroll") for (int n = 0; n < 2; ++n) _Pragma("unroll") for (int k = 0; k < 2; ++k) dst[n][k] = *(const PG8_LAS bf16x8*)(lds + PG8_SB(b, h) + boff + n * 2048 + k * 1024); } while (0)
#define PG8_MMA(ai, bj, At, Bt) do { __builtin_amdgcn_s_setprio(1); _Pragma("unroll") for (int m = 0; m < 4; ++m) _Pragma("unroll") for (int n = 0; n < 2; ++n) _Pragma("unroll") for (int k = 0; k < 2; ++k) \
        acc[ai][bj][m][n] = __builtin_amdgcn_mfma_f32_16x16x32_bf16(Bt[n][k], At[m][k], acc[ai][bj][m][n], 0, 0, 0); __builtin_amdgcn_s_setprio(0); } while (0)
#define PG8_WAIT_V(n) asm volatile("s_waitcnt vmcnt(" #n ")" ::: "memory")
#define PG8_WAIT_L(n) asm volatile("s_waitcnt lgkmcnt(" #n ")" ::: "memory")
#define PG8_BAR __builtin_amdgcn_s_barrier()
#define PG8_SCHED __builtin_amdgcn_sched_barrier(0)
    Unit cur, nxt; int ui = 0;
    if (!S.next(0, cur)) return;
    f32x4 acc[2][2][4][2];
#pragma unroll
    for (int a = 0; a < 2; ++a)
#pragma unroll
        for (int b = 0; b < 2; ++b)
#pragma unroll
            for (int m = 0; m < 4; ++m)
#pragma unroll
                for (int n = 0; n < 2; ++n) acc[a][b][m][n] = (f32x4){0.f, 0.f, 0.f, 0.f};
    bf16x8 At[4][2], B0[2][2], B1[2][2];
    const char* cA = (const char*)g.A + (size_t)cur.pm * tstep; const char* cB = (const char*)g.Bt + (size_t)cur.pn * tstep;
    S.a_ready(cur);
    if constexpr (SP2) {
        PG8_STAGE(PG8_SB(0, 0), cB, voffB); PG8_STAGE(PG8_SB(0, 1), cB + hstep, voffB); PG8_STAGE(PG8_SA(0, 0), cA, voffA); PG8_STAGE(PG8_SA(0, 1), cA + hstep, voffA);
        if (wr == 1) PG8_BAR;
        PG8_WAIT_V(2); PG8_BAR;
        PG8_STAGE(PG8_SB(1, 0), cB + kstep, voffB); PG8_STAGE(PG8_SA(1, 0), cA + kstep, voffA); PG8_STAGE(PG8_SB(1, 1), cB + hstep + kstep, voffB);
        PG8_WAIT_V(6); PG8_BAR;
    } else {
        PG8_STAGE(PG8_SB(0, 0), cB, voffB); PG8_STAGE(PG8_SA(0, 0), cA, voffA); PG8_STAGE(PG8_SB(0, 1), cB + hstep, voffB); PG8_STAGE(PG8_SA(0, 1), cA + hstep, voffA);
        if (wr == 1) PG8_BAR;
        PG8_WAIT_V(4); PG8_BAR;
        PG8_STAGE(PG8_SB(1, 0), cB + kstep, voffB); PG8_STAGE(PG8_SA(1, 0), cA + kstep, voffA); PG8_STAGE(PG8_SB(1, 1), cB + hstep + kstep, voffB);
        PG8_WAIT_V(6); PG8_BAR;
    }
    for (;;) {
        const bool has_next = S.next(ui + 1, nxt);
        const char* nA = has_next ? (const char*)g.A + (size_t)nxt.pm * tstep : cA; const char* nB = has_next ? (const char*)g.Bt + (size_t)nxt.pn * tstep : cB;
        for (int t = 0; t < nt; t += 2) {
            const bool last = (t == nt - 2);
            const char* a1 = cA + (size_t)(t + 1) * kstep;
            const char* a2 = last ? nA : cA + (size_t)(t + 2) * kstep; const char* b2 = last ? nB : cB + (size_t)(t + 2) * kstep;
            const char* a3 = a2 + kstep; const char* b3 = b2 + kstep;
            if (last && has_next) S.a_ready(nxt);
            if constexpr (SP2) {
            PG8_LDB(B0, 0, 0); PG8_LDB(B1, 0, 1); PG8_SCHED; PG8_LDA(At, 0, 0); PG8_STAGE(PG8_SA(1, 1), a1 + hstep, voffA);
            PG8_WAIT_V(8); PG8_WAIT_L(0); PG8_BAR; PG8_MMA(0, 0, At, B0); PG8_MMA(0, 1, At, B1); PG8_BAR; PG8_SCHED;
            PG8_LDA(At, 0, 1); PG8_STAGE(PG8_SB(0, 0), b2, voffB); PG8_STAGE(PG8_SB(0, 1), b2 + hstep, voffB); PG8_STAGE(PG8_SA(0, 0), a2, voffA);
            PG8_WAIT_V(8); PG8_WAIT_L(0); PG8_BAR; PG8_MMA(1, 0, At, B0); PG8_MMA(1, 1, At, B1); PG8_BAR; PG8_SCHED;
            PG8_LDB(B0, 1, 0); PG8_LDB(B1, 1, 1); PG8_SCHED; PG8_LDA(At, 1, 0); PG8_STAGE(PG8_SA(0, 1), a2 + hstep, voffA);
            PG8_WAIT_V(8); PG8_WAIT_L(0); PG8_BAR; PG8_MMA(0, 0, At, B0); PG8_MMA(0, 1, At, B1); PG8_BAR; PG8_SCHED;
            PG8_LDA(At, 1, 1); PG8_STAGE(PG8_SB(1, 0), b3, voffB); PG8_STAGE(PG8_SB(1, 1), b3 + hstep, voffB); PG8_STAGE(PG8_SA(1, 0), a3, voffA);
            PG8_WAIT_V(8); PG8_WAIT_L(0); PG8_BAR; PG8_MMA(1, 0, At, B0); PG8_MMA(1, 1, At, B1); PG8_BAR; PG8_SCHED;
            } else {
            PG8_LDB(B0, 0, 0); PG8_SCHED; PG8_LDA(At, 0, 0); PG8_STAGE(PG8_SA(1, 1), a1 + hstep, voffA);
            PG8_WAIT_L(8); PG8_BAR; PG8_WAIT_L(0); PG8_MMA(0, 0, At, B0); PG8_BAR; PG8_SCHED;
            PG8_LDB(B1, 0, 1); PG8_STAGE(PG8_SB(0, 0), b2, voffB);
            PG8_BAR; PG8_WAIT_L(0); PG8_MMA(0, 1, At, B1); PG8_BAR;
            PG8_LDA(At, 0, 1); PG8_STAGE(PG8_SA(0, 0), a2, voffA);
            PG8_BAR; PG8_WAIT_L(0); PG8_MMA(1, 0, At, B0); PG8_BAR; PG8_SCHED;
            PG8_STAGE(PG8_SB(0, 1), b2 + hstep, voffB);
            PG8_WAIT_V(6); PG8_BAR; PG8_MMA(1, 1, At, B1); PG8_BAR;
            PG8_LDB(B0, 1, 0); PG8_SCHED; PG8_LDA(At, 1, 0); PG8_STAGE(PG8_SA(0, 1), a2 + hstep, voffA);
            PG8_WAIT_L(8); PG8_BAR; PG8_WAIT_L(0); PG8_MMA(0, 0, At, B0); PG8_BAR; PG8_SCHED;
            PG8_LDB(B1, 1, 1); PG8_STAGE(PG8_SB(1, 0), b3, voffB);
            PG8_BAR; PG8_WAIT_L(0); PG8_MMA(0, 1, At, B1); PG8_BAR;
            PG8_LDA(At, 1, 1); PG8_STAGE(PG8_SA(1, 0), a3, voffA);
            PG8_BAR; PG8_WAIT_L(0); PG8_MMA(1, 0, At, B0); PG8_BAR; PG8_SCHED;
            PG8_STAGE(PG8_SB(1, 1), b3 + hstep, voffB);
            PG8_WAIT_V(6); PG8_BAR; PG8_MMA(1, 1, At, B1); PG8_BAR;
            }
        }
        if constexpr (ALIGN_EPI) { if (wr == 0) PG8_BAR; }
        if constexpr (!Epi::AFTER_DRAIN) { E(acc, cur, wr, wc, fr, fq); S.done(cur); }
        if (!has_next) break;
#pragma unroll
        for (int a = 0; a < 2; ++a)
#pragma unroll
            for (int b = 0; b < 2; ++b)
#pragma unroll
                for (int m = 0; m < 4; ++m)
#pragma unroll
                    for (int n = 0; n < 2; ++n) acc[a][b][m][n] = (f32x4){0.f, 0.f, 0.f, 0.f};
        cur = nxt; cA = nA; cB = nB; ++ui;
        if constexpr (ALIGN_EPI) { if (wr == 1) PG8_BAR; }
    }
    PG8_WAIT_V(0);
    if constexpr (!ALIGN_EPI) { if (wr == 0) PG8_BAR; }
    PG8_BAR;
    if constexpr (Epi::AFTER_DRAIN) { E.fused(acc, cur, wr, wc, fr, fq, lds, wid, lane); S.done(cur); }
#undef PG8_SA
#undef PG8_SB
#undef PG8_STAGE
#undef PG8_LDA
#undef PG8_LDB
#undef PG8_MMA
#undef PG8_WAIT_V
#undef PG8_WAIT_L
#undef PG8_BAR
#undef PG8_SCHED
}
}
struct Args { const void* in[N_IN]; float* out; unsigned char* ws; int ph_lo, ph_hi; };
typedef const __attribute__((address_space(4))) Args CArgs;

struct Ctx {
    LAS unsigned char* lds; int tid, lane, wave, G, bid;
};

DI const float* w_src(const CArgs& a, int m, int n, int& ld) {
    switch (m) {
    case 0: { ld = 3360; const float* W = (const float*)a.in[I_WINE]; int s;
              if (n < 1536) s = n; else if (n < CE_SMALL) s = n + 8; else if (n < CE_SMALL + 8) s = n - CE_SMALL + 1536; else if (n < 3360) s = n; else return nullptr;
              return W + s; }
    case 1: ld = DM; return (const float*)a.in[I_WOE] + n;
    case 2: { ld = 3088; const float* W = (const float*)a.in[I_WINO]; int s;
              if (n < 2048) s = n; else if (n < 3072) s = n + 16; else if (n < 3088) s = n - 3072 + 2048; else return nullptr;
              return W + s; }
    case 3: ld = DM; return (const float*)a.in[I_WOO] + n;
    case 4: case 5: { ld = DFF; const int l = m - 4, w = n & 255, f = (n >> 8) * 128 + (w & 127);
              return (w < 128 ? (const float*)a.in[I_FG] : (const float*)a.in[I_FU]) + (size_t)l * DM * DFF + f; }
    default: { ld = DM; const int l = m - 6; return (const float*)a.in[I_FD] + (size_t)l * DFF * DM + n; }
    }
}
DI bf16* w_dst(const CArgs& a, int m) {
    switch (m) {
    case 0: return (bf16*)(a.ws + WS_WINE); case 1: return (bf16*)(a.ws + WS_WOE); case 2: return (bf16*)(a.ws + WS_WINO); case 3: return (bf16*)(a.ws + WS_WOO);
    case 4: return (bf16*)(a.ws + WS_WGU); case 5: return (bf16*)(a.ws + WS_WGU + al((size_t)NGU * DM * 2));
    case 6: return (bf16*)(a.ws + WS_WD); default: return (bf16*)(a.ws + WS_WD + al((size_t)DM * DFF * 2));
    }
}
DI void p0_prologue(const CArgs& a, const Ctx& C) {
    LAS float* scr = (LAS float*)(C.lds + C.wave * 16384);
    const int gw = C.bid * NWAVES + C.wave, NGW = C.G * NWAVES, lane = C.lane;
    if (C.bid == 0 && C.tid == 0) ((unsigned*)(a.ws + WS_CTL))[CTL_QUEUE] = 0u;
    constexpr int IT0 = 16 * (NE / 32), IT1 = 16 * 32, IT2 = 16 * (NO / 32), IT3 = 16 * 32, IT4 = 16 * (NGU / 32), IT6 = (DFF / 64) * 32;
    constexpr int NIT = IT0 + IT1 + IT2 + IT3 + 2 * IT4 + 2 * IT6;
    for (int it = gw; it < NIT; it += NGW) {
        int r = it, m, K = DM, rows;
        if (r < IT0) { m = 0; rows = NE; } else if ((r -= IT0) < IT1) { m = 1; rows = DM; } else if ((r -= IT1) < IT2) { m = 2; rows = NO; } else if ((r -= IT2) < IT3) { m = 3; rows = DM; }
        else if ((r -= IT3) < IT4) { m = 4; rows = NGU; } else if ((r -= IT4) < IT4) { m = 5; rows = NGU; } else if ((r -= IT4) < IT6) { m = 6; rows = DM; K = DFF; } else { r -= IT6; m = 7; rows = DM; K = DFF; }
        const int nblk = rows / 32, kb = r / nblk, nb = r % nblk, k0 = 64 * kb, n0 = 32 * nb;
        int ld; const float* src = w_src(a, m, n0 + (lane & 31), ld);
#pragma unroll 8
        for (int i = 0; i < 32; ++i) { const int kk = 2 * i + (lane >> 5); scr[kk * 33 + (lane & 31)] = src ? src[(size_t)(k0 + kk) * ld] : 0.f; }
        LDS_WAIT(); asm volatile("" ::: "memory");
        const int c = lane & 7; bf16* WT = w_dst(a, m);
#pragma unroll
        for (int j = 0; j < 4; ++j) { const int n = (lane >> 3) + 8 * j; const LAS float* s = scr + (8 * c) * 33 + n;
            u32x4 o; o.x = pk2(s[0 * 33], s[1 * 33]); o.y = pk2(s[2 * 33], s[3 * 33]); o.z = pk2(s[4 * 33], s[5 * 33]); o.w = pk2(s[6 * 33], s[7 * 33]);
            *(u32x4*)(WT + (size_t)(n0 + n) * K + k0 + 8 * c) = o; }
        LDS_WAIT(); asm volatile("" ::: "memory");
    }
    bf16* XB = (bf16*)(a.ws + WS_XB);
    for (int row = gw; row < MT; row += NGW) {
        const float* xr = row < MP ? (const float*)a.in[I_XP] + (size_t)row * DM : row < MP + DB ? (const float*)a.in[I_XS] + (size_t)(row - MP) * DM : nullptr;
#pragma unroll
        for (int j = 0; j < 4; ++j) { f32x4 v = xr ? *(const f32x4*)(xr + 4 * lane + 256 * j) : (f32x4){0.f, 0.f, 0.f, 0.f};
            u32x2 w; w.x = pk2(v[0], v[1]); w.y = pk2(v[2], v[3]); *(u32x2*)(XB + (size_t)row * DM + 4 * lane + 256 * j) = w; }
    }
    const float* cache = (const float*)a.in[I_CACHE]; const int* pt = (const int*)a.in[I_PT]; float* KCBS = (float*)(a.ws + WS_KCBS);
    for (int u = gw; u < DB * 256; u += NGW) {
        const int b = u >> 8, c = u & 255, page = pt[b * NPAGE + (c >> 2)];
        const float* base = cache + ((size_t)page * 128 + (c & 3) * 32) * 512 + 4 * lane;
        f32x4 s = {0.f, 0.f, 0.f, 0.f};
#pragma unroll 8
        for (int i = 0; i < 32; ++i) s += *(const f32x4*)(base + (size_t)i * 512);
        *(f32x4*)(KCBS + (size_t)u * 256 + 4 * lane) = s * (1.f / 32.f);
    }
}

DI void ln_phase(const CArgs& a, const Ctx& C, int layer, int which) {
    const int gw = C.bid * NWAVES + C.wave, NGW = C.G * NWAVES, lane = C.lane;
    const float* g = (const float*)a.in[I_LNG] + (layer * 2 + which) * DM; const float* bb = (const float*)a.in[I_LNB] + (layer * 2 + which) * DM;
    const float* Y = (const float*)(a.ws + WS_Y); float* X1 = (float*)(a.ws + WS_X1); bf16* XB = (bf16*)(a.ws + WS_XB);
    const bool first = (layer == 0 && which == 0), last = (layer == 1 && which == 1);
    f32x4 gv[4], bv[4];
#pragma unroll
    for (int j = 0; j < 4; ++j) { gv[j] = *(const f32x4*)(g + 4 * lane + 256 * j); bv[j] = *(const f32x4*)(bb + 4 * lane + 256 * j); }
    for (int row = gw; row < MP + DB; row += NGW) {
        const float* xr = first ? (row < MP ? (const float*)a.in[I_XP] + (size_t)row * DM : (const float*)a.in[I_XS] + (size_t)(row - MP) * DM) : X1 + (size_t)row * DM;
        f32x4 v[4]; float s = 0.f;
#pragma unroll
        for (int j = 0; j < 4; ++j) { v[j] = *(const f32x4*)(xr + 4 * lane + 256 * j) * ALPHA + *(const f32x4*)(Y + (size_t)row * DM + 4 * lane + 256 * j); s += (v[j][0] + v[j][1]) + (v[j][2] + v[j][3]); }
        const float mean = wave_sum(s) * (1.f / DM); float q = 0.f;
#pragma unroll
        for (int j = 0; j < 4; ++j) { v[j] = v[j] - mean; q += (v[j][0] * v[j][0] + v[j][1] * v[j][1]) + (v[j][2] * v[j][2] + v[j][3] * v[j][3]); }
        const float rstd = 1.f / sqrtf(wave_sum(q) * (1.f / DM) + 1e-5f);
        float* orow = last ? (row < MP ? a.out + O_YP + (size_t)row * DM : a.out + O_YS + (size_t)(row - MP) * DM) : X1 + (size_t)row * DM;
#pragma unroll
        for (int j = 0; j < 4; ++j) { const f32x4 o = v[j] * rstd * gv[j] + bv[j]; *(f32x4*)(orow + 4 * lane + 256 * j) = o;
            if (!last) { u32x2 w; w.x = pk2(o[0], o[1]); w.y = pk2(o[2], o[3]); *(u32x2*)(XB + (size_t)row * DM + 4 * lane + 256 * j) = w; } }
    }
}
DI int crow(int reg, int h) { return (reg & 3) + 8 * (reg >> 2) + 4 * h; }
template <int K> DI f32x16 mm_tile(const LAS bf16* A, int lda, const LAS bf16* B, int ldb, f32x16 acc, int lane) {
    const int r = lane & 31, h = lane >> 5;
#pragma unroll
    for (int k0 = 0; k0 < K; k0 += 16) {
        const bf16x8 av = *(const LAS bf16x8*)(A + r * lda + k0 + 8 * h);
        const bf16x8 bv = *(const LAS bf16x8*)(B + r * ldb + k0 + 8 * h);
        acc = __builtin_amdgcn_mfma_f32_32x32x16_bf16(av, bv, acc, 0, 0, 0);
    }
    return acc;
}
DI float softplusf_(float x) { return x > 20.f ? x : log1pf(__expf(x)); }
DI float logsigmoidf_(float x) { return fminf(x, 0.f) - log1pf(__expf(-fabsf(x))); }
constexpr int CK_NW = 0, CK_QG = 16384, CK_QK = 32768, CK_KDT = 40960, CK_UT = 57344, CK_GL = 73728;
constexpr int GK_QT = 0, GK_KDT = 16384, GK_ATT = 32768, GK_GL = 40960;
constexpr int LDA = 136, LDT = 72;
DI void delta_chunk_prep(const CArgs& a, const Ctx& C, int unit) {
    const int b = unit >> 7, h = (unit >> 5) & 3, n = unit & 31, tid = C.tid, lane = C.lane, wave = C.wave;
    const int row0 = b * SEQ + n * 64;
    const bf16* H = (const bf16*)(a.ws + WS_H); const float* HS = (const float*)(a.ws + WS_HS);
    unsigned char* ck = a.ws + WS_CHK + (size_t)unit * CHK_BYTES;
    LAS bf16* Qs = (LAS bf16*)(C.lds); LAS bf16* Ks = (LAS bf16*)(C.lds + 17408); LAS bf16* KBG = (LAS bf16*)(C.lds + 34816); LAS bf16* VBt = (LAS bf16*)(C.lds + 53248);
    LAS float* Am = (LAS float*)(C.lds + 71680); LAS bf16* Ts = (LAS bf16*)(C.lds + 89088); LAS bf16* KDs = (LAS bf16*)(C.lds + 98304);
    LAS float* sm = (LAS float*)(C.lds + 116736);
    if (wave == 0) {
        const float* hs = HS + (size_t)(row0 + lane) * 32;
        const float beta = sigmoidf_(hs[h]);
        float g = -__expf(((const float*)a.in[I_ALOG])[h]) * softplusf_(hs[4 + h] + ((const float*)a.in[I_DTB])[h]);
#pragma unroll
        for (int o = 1; o < 64; o <<= 1) { const float t = __shfl_up(g, o); if (lane >= o) g += t; }
        sm[lane] = beta; sm[64 + lane] = g;
    }
    __syncthreads();
    const float gam_last = sm[64 + 63];
    {
        const float* cw = (const float*)a.in[I_CONVW];
        float wq[4][2], wk[4][2], wv[4][2];
#pragma unroll
        for (int j = 0; j < 4; ++j) { const float* c0 = cw + j * 1536 + h * 128 + 2 * lane;
            wq[j][0] = c0[0]; wq[j][1] = c0[1]; wk[j][0] = c0[512]; wk[j][1] = c0[513]; wv[j][0] = c0[1024]; wv[j][1] = c0[1025]; }
        for (int rr = 0; rr < 8; ++rr) {
            const int i = wave * 8 + rr, t = n * 64 + i;
            float q0 = 0.f, q1 = 0.f, k0 = 0.f, k1 = 0.f, v0 = 0.f, v1 = 0.f;
#pragma unroll
            for (int j = 0; j < 4; ++j) { const int tt = t - 3 + j;
                if (tt >= 0) { const bf16* hr = H + (size_t)(b * SEQ + tt) * NE + h * 128 + 2 * lane;
                    const unsigned xq = *(const unsigned*)(hr), xk = *(const unsigned*)(hr + 512), xv = *(const unsigned*)(hr + 1024);
                    q0 += bflo(xq) * wq[j][0]; q1 += bfhi(xq) * wq[j][1]; k0 += bflo(xk) * wk[j][0]; k1 += bfhi(xk) * wk[j][1]; v0 += bflo(xv) * wv[j][0]; v1 += bfhi(xv) * wv[j][1]; } }
            q0 = siluf_(q0); q1 = siluf_(q1); k0 = siluf_(k0); k1 = siluf_(k1); v0 = siluf_(v0); v1 = siluf_(v1);
            const float qn = rsqrtf(wave_sum(q0 * q0 + q1 * q1) + 1e-6f) * 0.08838834764831845f, kn = rsqrtf(wave_sum(k0 * k0 + k1 * k1) + 1e-6f);
            q0 *= qn; q1 *= qn; k0 *= kn; k1 *= kn;
            const float beta = sm[i], gam = sm[64 + i], eg = __expf(gam), ed = __expf(gam_last - gam);
            *(LAS unsigned*)(Qs + i * LDA + 2 * lane) = pk2(q0, q1);
            *(LAS unsigned*)(Ks + i * LDA + 2 * lane) = pk2(k0, k1);
            KBG[(2 * lane) * LDT + i] = (bf16)f2bf(k0 * beta * eg); KBG[(2 * lane + 1) * LDT + i] = (bf16)f2bf(k1 * beta * eg);
            VBt[(2 * lane) * LDT + i] = (bf16)f2bf(v0 * beta); VBt[(2 * lane + 1) * LDT + i] = (bf16)f2bf(v1 * beta);
            KDs[(2 * lane) * LDT + i] = (bf16)f2bf(k0 * ed); KDs[(2 * lane + 1) * LDT + i] = (bf16)f2bf(k1 * ed);
            *(unsigned*)(ck + CK_QG + (i * 128 + 2 * lane) * 2) = pk2(q0 * eg, q1 * eg);
        }
        if (tid == 0) *(float*)(ck + CK_GL) = __expf(gam_last);
    }
    __syncthreads();
    for (int x = tid; x < 128 * 8; x += NTHREADS) { const int d = x >> 3, c8 = x & 7; *(u32x4*)(ck + CK_KDT + (d * 64 + c8 * 8) * 2) = *(const LAS u32x4*)(KDs + d * LDT + c8 * 8); }
    {
        const int ti = (wave >> 1) & 1, tj = wave & 1, r = lane & 31, hh = lane >> 5; const bool isqk = wave >= 4;
        f32x16 acc = {};
        acc = mm_tile<128>((isqk ? Qs : Ks) + ti * 32 * LDA, LDA, Ks + tj * 32 * LDA, LDA, acc, lane);
        const int j = tj * 32 + r; const float gj = sm[64 + j];
#pragma unroll
        for (int reg = 0; reg < 16; ++reg) { const int i = ti * 32 + crow(reg, hh); const float gi = sm[64 + i];
            if (isqk) { const float v = (i >= j) ? acc[reg] * __expf(gi - gj) : 0.f; *(bf16*)(ck + CK_QK + (i * 64 + j) * 2) = (bf16)f2bf(v); }
            else { const float v = (i > j) ? acc[reg] * sm[i] * __expf(gi - gj) : 0.f; Am[i * 68 + j] = v; } }
    }
    __syncthreads();
    if (wave == 0) {
        float T[64];
#pragma unroll
        for (int i = 0; i < 64; ++i) {
            float acc = (i == lane) ? 1.f : 0.f;
#pragma unroll
            for (int j4 = 0; j4 < i; j4 += 4) { const f32x4 av = *(const LAS f32x4*)(Am + i * 68 + j4);
                acc -= av[0] * T[j4]; if (j4 + 1 < i) acc -= av[1] * T[j4 + 1]; if (j4 + 2 < i) acc -= av[2] * T[j4 + 2]; if (j4 + 3 < i) acc -= av[3] * T[j4 + 3]; }
            T[i] = acc;
            Ts[i * LDT + lane] = (bf16)f2bf(acc);
        }
    }
    __syncthreads();
    {
        const int ti = wave >> 2, tc = wave & 3, r = lane & 31, hh = lane >> 5;
        f32x16 u = {}, w = {};
        u = mm_tile<64>(Ts + ti * 32 * LDT, LDT, VBt + tc * 32 * LDT, LDT, u, lane);
        w = mm_tile<64>(Ts + ti * 32 * LDT, LDT, KBG + tc * 32 * LDT, LDT, w, lane);
        const int col = tc * 32 + r;
#pragma unroll
        for (int g4 = 0; g4 < 4; ++g4) { u32x2 pk; pk.x = pk2(u[4 * g4], u[4 * g4 + 1]); pk.y = pk2(u[4 * g4 + 2], u[4 * g4 + 3]);
            *(u32x2*)(ck + CK_UT + (col * 64 + ti * 32 + 8 * g4 + 4 * hh) * 2) = pk; }
#pragma unroll
        for (int reg = 0; reg < 16; ++reg) { const int i = ti * 32 + crow(reg, hh); *(bf16*)(ck + CK_NW + (i * 128 + col) * 2) = (bf16)f2bf(-w[reg]); }
    }
    __syncthreads();
}
DI void prep_even(const CArgs& a, const Ctx& C) {
    for (int u = C.bid; u < 1024 + 64 + 256; u += C.G) {
        if (u < 1024) delta_chunk_prep(a, C, u);
        else if (u < 1088) {
            const int item = (u - 1024) * 8 + C.wave, b = item >> 6, cb = item & 63, lane = C.lane;
            const bf16* base = (const bf16*)(a.ws + WS_H) + (size_t)(b * SEQ + cb * 32) * NE + CE_KV + 4 * lane;
            float s0 = 0.f, s1 = 0.f, s2 = 0.f, s3 = 0.f;
#pragma unroll 8
            for (int i = 0; i < 32; ++i) { const u32x2 x = *(const u32x2*)(base + (size_t)i * NE); s0 += bflo(x.x); s1 += bfhi(x.x); s2 += bflo(x.y); s3 += bfhi(x.y); }
            s0 *= (1.f / 32.f); s1 *= (1.f / 32.f); s2 *= (1.f / 32.f); s3 *= (1.f / 32.f);
            *(f32x4*)((float*)(a.ws + WS_KCBP) + (size_t)item * 256 + 4 * lane) = (f32x4){s0, s1, s2, s3};
            const int g = (lane >> 4) & 1, d = (lane & 15) * 4;
            if (lane < 32) { u32x2 w; w.x = pk2(s0, s1); w.y = pk2(s2, s3); *(u32x2*)((bf16*)(a.ws + WS_KCB) + ((size_t)(b * 2 + g) * 64 + cb) * 64 + d) = w; }
            else { bf16* vt = (bf16*)(a.ws + WS_VCBT) + ((size_t)(b * 2 + g) * 64 + d) * 64 + cb; vt[0] = (bf16)f2bf(s0); vt[64] = (bf16)f2bf(s1); vt[128] = (bf16)f2bf(s2); vt[192] = (bf16)f2bf(s3); }
        } else {
            const int uu = u - 1088, b = uu >> 5, tb = uu & 31, tid = C.tid; LAS bf16* TR = (LAS bf16*)C.lds;
            { const int t = tid >> 3, c8 = tid & 7; const bf16* hr = (const bf16*)(a.ws + WS_H) + (size_t)(b * SEQ + tb * 64 + t) * NE + CE_KV + c8 * 8;
#pragma unroll
              for (int tile = 0; tile < 4; ++tile) { const int br = tile >> 1, g = tile & 1; const u32x4 x = *(const u32x4*)(hr + 384 + 256 * br + g * 64); const unsigned w[4] = {x.x, x.y, x.z, x.w};
#pragma unroll
                  for (int k = 0; k < 4; ++k) { TR[(tile * 64 + c8 * 8 + 2 * k) * LDT + t] = (bf16)(w[k] & 0xffffu); TR[(tile * 64 + c8 * 8 + 2 * k + 1) * LDT + t] = (bf16)(w[k] >> 16); } } }
            __syncthreads();
            { const int d = tid >> 3, c8 = tid & 7;
#pragma unroll
              for (int tile = 0; tile < 4; ++tile) { const int br = tile >> 1, g = tile & 1; bf16* dst = (bf16*)(a.ws + (br ? WS_VTW : WS_VTS)) + ((size_t)(b * 2 + g) * 64 + d) * SEQ + tb * 64 + c8 * 8;
                  *(u32x4*)dst = *(const LAS u32x4*)(TR + (tile * 64 + d) * LDT + c8 * 8); } }
            __syncthreads();
        }
    }
}
DI void delta_scan(const CArgs& a, const Ctx& C, int unit) {
    const int b = unit >> 2, h = unit & 3, tid = C.tid, lane = C.lane, wave = C.wave, p = wave >> 1, hf = wave & 1, r = lane & 31, hh = lane >> 5;
    LAS bf16* STs = (LAS bf16*)(C.lds); LAS bf16* NWs = (LAS bf16*)(C.lds + 34816); LAS bf16* QGs = (LAS bf16*)(C.lds + 52224); LAS bf16* QKs = (LAS bf16*)(C.lds + 69632);
    LAS bf16* KDs = (LAS bf16*)(C.lds + 78848); LAS bf16* UTs = (LAS bf16*)(C.lds + 97280); LAS bf16* VNT = (LAS bf16*)(C.lds + 115712); LAS float* OB = (LAS float*)(C.lds + 34816);
    const bf16* H = (const bf16*)(a.ws + WS_H); bf16* MIX = (bf16*)(a.ws + WS_MIX); const float* dng = (const float*)a.in[I_DNG];
    f32x16 S0 = {}, S1 = {};
    for (int x = tid; x < 128 * LDA / 2; x += NTHREADS) ((LAS unsigned*)STs)[x] = 0u;
    for (int n = 0; n < 32; ++n) {
        const unsigned char* ck = a.ws + WS_CHK + (size_t)(unit * 32 + n) * CHK_BYTES;
        for (int x = tid; x < 1024; x += NTHREADS) { const int rw = x >> 4, c8 = x & 15;
            *(LAS u32x4*)(NWs + rw * LDA + c8 * 8) = *(const u32x4*)(ck + CK_NW + x * 16);
            *(LAS u32x4*)(QGs + rw * LDA + c8 * 8) = *(const u32x4*)(ck + CK_QG + x * 16); }
        for (int x = tid; x < 1024; x += NTHREADS) { const int rw = x >> 3, c8 = x & 7;
            *(LAS u32x4*)(KDs + rw * LDT + c8 * 8) = *(const u32x4*)(ck + CK_KDT + x * 16);
            *(LAS u32x4*)(UTs + rw * LDT + c8 * 8) = *(const u32x4*)(ck + CK_UT + x * 16); }
        { const int x = tid, rw = x >> 3, c8 = x & 7; *(LAS u32x4*)(QKs + rw * LDT + c8 * 8) = *(const u32x4*)(ck + CK_QK + x * 16); }
        const float gl = *(const float*)(ck + CK_GL);
        __syncthreads();
        f32x16 vn, o = {};
#pragma unroll
        for (int g4 = 0; g4 < 4; ++g4) { const u32x2 x = *(const LAS u32x2*)(UTs + (32 * p + r) * LDT + 32 * hf + 8 * g4 + 4 * hh);
            vn[4 * g4] = bflo(x.x); vn[4 * g4 + 1] = bfhi(x.x); vn[4 * g4 + 2] = bflo(x.y); vn[4 * g4 + 3] = bfhi(x.y); }
        vn = mm_tile<128>(NWs + 32 * hf * LDA, LDA, STs + 32 * p * LDA, LDA, vn, lane);
        o = mm_tile<128>(QGs + 32 * hf * LDA, LDA, STs + 32 * p * LDA, LDA, o, lane);
#pragma unroll
        for (int g4 = 0; g4 < 4; ++g4) { u32x2 pk; pk.x = pk2(vn[4 * g4], vn[4 * g4 + 1]); pk.y = pk2(vn[4 * g4 + 2], vn[4 * g4 + 3]);
            *(LAS u32x2*)(VNT + (32 * p + r) * LDT + 32 * hf + 8 * g4 + 4 * hh) = pk; }
        __syncthreads();
        o = mm_tile<64>(QKs + 32 * hf * LDT, LDT, VNT + 32 * p * LDT, LDT, o, lane);
        S0 = S0 * gl; S1 = S1 * gl;
        S0 = mm_tile<64>(KDs + (64 * hf) * LDT, LDT, VNT + 32 * p * LDT, LDT, S0, lane);
        S1 = mm_tile<64>(KDs + (64 * hf + 32) * LDT, LDT, VNT + 32 * p * LDT, LDT, S1, lane);
#pragma unroll
        for (int reg = 0; reg < 16; ++reg) OB[(32 * hf + crow(reg, hh)) * 132 + 32 * p + r] = o[reg];
#pragma unroll
        for (int g4 = 0; g4 < 4; ++g4) { u32x2 pk; pk.x = pk2(S0[4 * g4], S0[4 * g4 + 1]); pk.y = pk2(S0[4 * g4 + 2], S0[4 * g4 + 3]);
            *(LAS u32x2*)(STs + (32 * p + r) * LDA + 64 * hf + 8 * g4 + 4 * hh) = pk;
            pk.x = pk2(S1[4 * g4], S1[4 * g4 + 1]); pk.y = pk2(S1[4 * g4 + 2], S1[4 * g4 + 3]);
            *(LAS u32x2*)(STs + (32 * p + r) * LDA + 64 * hf + 32 + 8 * g4 + 4 * hh) = pk; }
        __syncthreads();
        { const int i = tid >> 3, seg = tid & 7, row = b * SEQ + n * 64 + i; float v[16], ss = 0.f;
#pragma unroll
          for (int k = 0; k < 16; ++k) { v[k] = OB[i * 132 + seg * 16 + k]; ss += v[k] * v[k]; }
          ss += __shfl_xor(ss, 1); ss += __shfl_xor(ss, 2); ss += __shfl_xor(ss, 4);
          const float rs = rsqrtf(ss * (1.f / 128.f) + 1e-6f);
          const bf16* gp = H + (size_t)row * NE + CE_GATE + h * 128 + seg * 16; const u32x4 g0 = *(const u32x4*)gp, g1 = *(const u32x4*)(gp + 8);
          const unsigned gw[8] = {g0.x, g0.y, g0.z, g0.w, g1.x, g1.y, g1.z, g1.w}; unsigned ow[8];
#pragma unroll
          for (int k = 0; k < 8; ++k) { const float ga = bflo(gw[k]), gb = bfhi(gw[k]);
              ow[k] = pk2(v[2 * k] * rs * dng[seg * 16 + 2 * k] * siluf_(ga), v[2 * k + 1] * rs * dng[seg * 16 + 2 * k + 1] * siluf_(gb)); }
          bf16* op = MIX + (size_t)row * DM + h * 128 + seg * 16;
          *(u32x4*)op = (u32x4){ow[0], ow[1], ow[2], ow[3]}; *(u32x4*)(op + 8) = (u32x4){ow[4], ow[5], ow[6], ow[7]}; }
        __syncthreads();
    }
    float* So = a.out + O_DS_P + (size_t)unit * 128 * 128;
#pragma unroll
    for (int reg = 0; reg < 16; ++reg) { So[(size_t)(64 * hf + crow(reg, hh)) * 128 + 32 * p + r] = S0[reg]; So[(size_t)(64 * hf + 32 + crow(reg, hh)) * 128 + 32 * p + r] = S1[reg]; }
}

DI void delta_sample(const CArgs& a, const Ctx& C, int unit) {
    const int b = unit >> 2, h = unit & 3, tid = C.tid, lane = C.lane, wave = C.wave, row = MP + b;
    LAS float* raw = (LAS float*)C.lds;
    LAS float* part = raw + 384;
    LAS float* misc = part + 1024;
    const bf16* H = (const bf16*)(a.ws + WS_H); const float* HS = (const float*)(a.ws + WS_HS);
    const float* cst = (const float*)a.in[I_DCONV] + (size_t)b * 3 * 1536; const float* cw = (const float*)a.in[I_CONVW];
    if (tid < 384) { const int ch = (tid >> 7) * 512 + h * 128 + (tid & 127);
        float y = cst[ch] * cw[ch] + cst[1536 + ch] * cw[1536 + ch] + cst[3072 + ch] * cw[3072 + ch] + bf2f(H[(size_t)row * NE + ch]) * cw[4608 + ch];
        raw[tid] = siluf_(y);
        a.out[O_DCONV_S + ((size_t)b * 3 + 0) * 1536 + ch] = cst[1536 + ch]; a.out[O_DCONV_S + ((size_t)b * 3 + 1) * 1536 + ch] = cst[3072 + ch]; }
    __syncthreads();
    if (wave < 2) { const float x0 = raw[wave * 128 + lane], x1 = raw[wave * 128 + 64 + lane]; const float nrm = rsqrtf(wave_sum(x0 * x0 + x1 * x1) + 1e-6f) * (wave == 0 ? 0.08838834764831845f : 1.f);
        raw[wave * 128 + lane] = x0 * nrm; raw[wave * 128 + 64 + lane] = x1 * nrm; }
    __syncthreads();
    const float beta = sigmoidf_(HS[(size_t)row * 32 + h]);
    const float g = -__expf(((const float*)a.in[I_ALOG])[h]) * softplusf_(HS[(size_t)row * 32 + 4 + h] + ((const float*)a.in[I_DTB])[h]);
    const float eg = __expf(g);
    const float* S0 = (const float*)a.in[I_DS] + (size_t)unit * 128 * 128;
    const int e = tid & 127, pt = tid >> 7;
    { float ks = 0.f, qs = 0.f;
#pragma unroll 8
      for (int d = pt * 32; d < pt * 32 + 32; ++d) { const float s = S0[d * 128 + e]; ks += raw[128 + d] * s; qs += raw[d] * s; }
      part[pt * 128 + e] = ks; part[512 + pt * 128 + e] = qs; }
    if (wave == 2) { const float qk = wave_sum(raw[lane] * raw[128 + lane] + raw[64 + lane] * raw[192 + lane]); if (lane == 0) misc[256] = qk; }
    __syncthreads();
    if (tid < 128) { const float ks = (part[e] + part[128 + e]) + (part[256 + e] + part[384 + e]), qs = (part[512 + e] + part[640 + e]) + (part[768 + e] + part[896 + e]);
        const float vn = beta * (raw[256 + e] - eg * ks); misc[e] = vn; misc[128 + e] = eg * qs + misc[256] * vn; }
    __syncthreads();
    { float* So = a.out + O_DS_S + (size_t)unit * 128 * 128; const float vn = misc[e];
#pragma unroll 8
      for (int d = pt * 32; d < pt * 32 + 32; ++d) So[d * 128 + e] = S0[d * 128 + e] * eg + raw[128 + d] * vn; }
    if (wave == 0) { const float o0 = misc[128 + lane], o1 = misc[192 + lane]; const float rs = rsqrtf(wave_sum(o0 * o0 + o1 * o1) * (1.f / 128.f) + 1e-6f);
        const float* dng = (const float*)a.in[I_DNG]; const bf16* gp = H + (size_t)row * NE + CE_GATE + h * 128; bf16* op = (bf16*)(a.ws + WS_MIX) + (size_t)row * DM + h * 128;
        op[lane] = (bf16)f2bf(o0 * rs * dng[lane] * siluf_(bf2f(gp[lane]))); op[64 + lane] = (bf16)f2bf(o1 * rs * dng[64 + lane] * siluf_(bf2f(gp[64 + lane]))); }
    __syncthreads();
}
constexpr float NSA_C = 0.125f * 1.4426950408889634f;
struct AttSt { float m, l; f32x16 o0, o1; };
DI bf16x8 pack8p(const f32x16& p, int s) {
    u32x4 w; w.x = pk2(p[8 * s], p[8 * s + 1]); w.y = pk2(p[8 * s + 2], p[8 * s + 3]); w.z = pk2(p[8 * s + 4], p[8 * s + 5]); w.w = pk2(p[8 * s + 6], p[8 * s + 7]); return __builtin_bit_cast(bf16x8, w); }
#define C0(reg) (((reg) & 3) + 8 * ((reg) >> 2))
template <bool EXPORT> DI void att_tile(const LAS bf16* Kt, const LAS bf16* Vt, const bf16x8 (&qf)[4], AttSt& st, int lane, int off, unsigned span, LAS float* pimp) {
    const int r = lane & 31, h = lane >> 5;
    f32x16 p0 = {}, p1 = {};
    { const LAS bf16* kp = Kt + r * 72 + 8 * h;
#pragma unroll
      for (int s = 0; s < 4; ++s) {
        const bf16x8 k0 = *(const LAS bf16x8*)(kp + 16 * s), k1 = *(const LAS bf16x8*)(kp + 32 * 72 + 16 * s);
        p0 = __builtin_amdgcn_mfma_f32_32x32x16_bf16(k0, qf[s], p0, 0, 0, 0);
        p1 = __builtin_amdgcn_mfma_f32_32x32x16_bf16(k1, qf[s], p1, 0, 0, 0);
      } }
#define NSA_VALID(c) ((unsigned)((c) + off) <= span)
    float mx = -3e38f;
#pragma unroll
    for (int reg = 0; reg < 16; ++reg) { if (NSA_VALID(C0(reg))) mx = fmaxf(mx, p0[reg]); if (NSA_VALID(C0(reg) + 32)) mx = fmaxf(mx, p1[reg]); }
    mx = fmaxf(mx, __shfl_xor(mx, 32));
    const float mn = fmaxf(st.m, mx), alpha = __builtin_amdgcn_exp2f((st.m - mn) * NSA_C), mC = mn * NSA_C;
    float ls = 0.f;
#pragma unroll
    for (int reg = 0; reg < 16; ++reg) {
        p0[reg] = NSA_VALID(C0(reg)) ? __builtin_amdgcn_exp2f(p0[reg] * NSA_C - mC) : 0.f; p1[reg] = NSA_VALID(C0(reg) + 32) ? __builtin_amdgcn_exp2f(p1[reg] * NSA_C - mC) : 0.f; ls += p0[reg] + p1[reg]; }
    ls += __shfl_xor(ls, 32);
    st.l = st.l * alpha + ls; st.m = mn; st.o0 *= alpha; st.o1 *= alpha;
    if (EXPORT) { const float inv = st.l > 0.f ? 1.f / st.l : 0.f; LAS float* pb = pimp + h * 256;
#pragma unroll
        for (int reg = 0; reg < 16; ++reg) { pb[C0(reg) * 64] = p0[reg] * inv; pb[(32 + C0(reg)) * 64] = p1[reg] * inv; } }
    const LAS bf16* vb = Vt + r * 68 + 4 * h;
#pragma unroll
    for (int u = 0; u < 2; ++u)
#pragma unroll
        for (int s = 0; s < 2; ++s) { const bf16x8 pf = pack8p(u ? p1 : p0, s);
#pragma unroll
            for (int dt = 0; dt < 2; ++dt) { const LAS bf16* vp = vb + 32 * dt * 68 + 32 * u + 16 * s;
                const s16x4 lo = *(const LAS s16x4*)vp, hi = *(const LAS s16x4*)(vp + 8);
                const bf16x8 vf = __builtin_shufflevector(lo, hi, 0, 1, 2, 3, 4, 5, 6, 7);
                if (dt == 0) st.o0 = __builtin_amdgcn_mfma_f32_32x32x16_bf16(vf, pf, st.o0, 0, 0, 0); else st.o1 = __builtin_amdgcn_mfma_f32_32x32x16_bf16(vf, pf, st.o1, 0, 0, 0); } }
#undef NSA_VALID
}
DI void mk_range(int lo, int hi, int h, int& off, unsigned& span) { if (hi < lo) { off = -100000; span = 0u; } else { off = 4 * h - lo; span = (unsigned)(hi - lo); } }
DI void nsa_unit(const CArgs& a, const Ctx& C, int b, int g, int qt) {
    const int tid = C.tid, lane = C.lane, wave = C.wave, r = lane & 31, h = lane >> 5, hq = wave >> 1, qh = wave & 1, qq = 32 * qh + r, qpos = 64 * qt + qq, head = 4 * g + hq, row = b * SEQ + qpos;
    LAS bf16* KB0 = (LAS bf16*)C.lds; LAS bf16* VB0 = (LAS bf16*)(C.lds + 18432);
    LAS float* PIMP = (LAS float*)(C.lds + 36864); LAS float* SCORE = (LAS float*)(C.lds + 102400); LAS int* SELN = (LAS int*)(C.lds + 110848);
    const bf16* H = (const bf16*)(a.ws + WS_H); const float* HS = (const float*)(a.ws + WS_HS);
    bf16x8 qf[4];
    { const bf16* qp = H + (size_t)row * NE + CE_QB + head * 64 + 8 * h;
#pragma unroll
      for (int s = 0; s < 4; ++s) qf[s] = *(const bf16x8*)(qp + 16 * s); }
    const float* gp = HS + (size_t)row * 32 + 8 + head * 3; const float gt0 = sigmoidf_(gp[0]), gt1 = sigmoidf_(gp[1]), gt2 = sigmoidf_(gp[2]);
    const int skey = tid >> 3, sc8 = tid & 7;
    f32x16 acc0 = {}, acc1 = {};
#define ST_INIT(st) do { st.m = -3e38f; st.l = 0.f; st.o0 = f32x16{}; st.o1 = f32x16{}; } while (0)
#define ST_FOLD(st, gate) do { const float w_ = st.l > 0.f ? (gate) / st.l : 0.f; acc0 += st.o0 * w_; acc1 += st.o1 * w_; } while (0)
#define LWRITE(buf, kr, vr) do { *(LAS u32x4*)(KB0 + (buf) * 4608 + skey * 72 + sc8 * 8) = kr; *(LAS u32x2*)(VB0 + (buf) * 4352 + skey * 68 + sc8 * 8) = (u32x2){vr.x, vr.y}; *(LAS u32x2*)(VB0 + (buf) * 4352 + skey * 68 + sc8 * 8 + 4) = (u32x2){vr.z, vr.w}; } while (0)
    { const u32x4 kr = *(const u32x4*)((const bf16*)(a.ws + WS_KCB) + ((size_t)(b * 2 + g) * 64 + skey) * 64 + sc8 * 8);
      const u32x4 vr = *(const u32x4*)((const bf16*)(a.ws + WS_VCBT) + ((size_t)(b * 2 + g) * 64 + skey) * 64 + sc8 * 8);
      LWRITE(0, kr, vr); }
    __syncthreads();
    { AttSt st; ST_INIT(st); int off; unsigned span; mk_range(0, (qpos + 1) / 32 - 1, h, off, span); att_tile<true>(KB0, VB0, qf, st, lane, off, span, PIMP + hq * 4096 + qq); ST_FOLD(st, gt0); }
    __syncthreads();
    { const int q = tid & 63, jg = tid >> 6;
#pragma unroll
      for (int k = 0; k < 4; ++k) { const int j = 4 * jg + k, c0 = 2 * j, c1 = c0 + 1;
          const float i0 = ((PIMP[c0 * 64 + q] + PIMP[4096 + c0 * 64 + q]) + PIMP[8192 + c0 * 64 + q]) + PIMP[12288 + c0 * 64 + q];
          const float i1 = ((PIMP[c1 * 64 + q] + PIMP[4096 + c1 * 64 + q]) + PIMP[8192 + c1 * 64 + q]) + PIMP[12288 + c1 * 64 + q];
          const bool forced = (j == 0) || (j == qt) || (j == qt - 1), valid = j <= qt;
          SCORE[q * 33 + j] = forced ? 1e9f : (valid ? i0 + i1 : -1e30f); }
      __syncthreads();
      int nib = 0;
#pragma unroll
      for (int k = 0; k < 4; ++k) { const int j = 4 * jg + k; const float sj = SCORE[q * 33 + j]; int rank = 0;
#pragma unroll 8
          for (int i = 0; i < 32; ++i) { const float si = SCORE[q * 33 + i]; rank += (si > sj || (si == sj && i < j)) ? 1 : 0; }
          nib |= (rank < 16 ? 1 : 0) << k; }
      SELN[q * 8 + jg] = nib; }
    __syncthreads();
    unsigned selmask = 0u;
#pragma unroll
    for (int jg = 0; jg < 8; ++jg) selmask |= (unsigned)SELN[qq * 8 + jg] << (4 * jg);
    {
        const int nsel = qt + 1, wj0 = max(0, qt - 8), ntot = nsel + (qt - wj0 + 1);
        const bf16* kbase = H + (size_t)(b * SEQ + skey) * NE + CE_KV + 256 + g * 64 + sc8 * 8;
        const size_t vrow = ((size_t)(b * 2 + g) * 64 + skey) * SEQ + sc8 * 8;
        const bf16* vts = (const bf16*)(a.ws + WS_VTS) + vrow; const bf16* vtw = (const bf16*)(a.ws + WS_VTW) + vrow;
        u32x4 kr = *(const u32x4*)kbase, vr = *(const u32x4*)vts;
        LWRITE(0, kr, vr);
        __syncthreads();
        AttSt st; ST_INIT(st);
        for (int t = 0; t < ntot; ++t) {
            if (t + 1 < ntot) { const int t1 = t + 1; const bool w1 = t1 >= nsel; const int jn = w1 ? wj0 + (t1 - nsel) : t1;
                kr = *(const u32x4*)(kbase + (w1 ? 256 : 0) + (size_t)jn * 64 * NE); vr = *(const u32x4*)((w1 ? vtw : vts) + jn * 64); }
            if (t == nsel) { ST_FOLD(st, gt1); ST_INIT(st); }
            const bool win = t >= nsel; const int j = win ? wj0 + (t - nsel) : t;
            int lo = 0, hi = 63;
            if (j == qt) hi = qq;
            if (win) { if (j == qt - 8) lo = qq + 1; } else if (!((selmask >> j) & 1u)) hi = -1;
            int off; unsigned span; mk_range(lo, hi, h, off, span);
            att_tile<false>(KB0 + (t & 1) * 4608, VB0 + (t & 1) * 4352, qf, st, lane, off, span, nullptr);
            if (t + 1 < ntot) LWRITE((t + 1) & 1, kr, vr);
            __syncthreads();
        }
        ST_FOLD(st, gt2);
    }
    bf16* op = (bf16*)(a.ws + WS_MIX) + (size_t)row * DM + 512 + head * 64;
#pragma unroll
    for (int g4 = 0; g4 < 4; ++g4) { u32x2 w; w.x = pk2(acc0[4 * g4], acc0[4 * g4 + 1]); w.y = pk2(acc0[4 * g4 + 2], acc0[4 * g4 + 3]); *(u32x2*)(op + 8 * g4 + 4 * h) = w;
        w.x = pk2(acc1[4 * g4], acc1[4 * g4 + 1]); w.y = pk2(acc1[4 * g4 + 2], acc1[4 * g4 + 3]); *(u32x2*)(op + 32 + 8 * g4 + 4 * h) = w; }
#undef ST_INIT
#undef ST_FOLD
#undef LWRITE
}
DI float kdot_bf16(const bf16* kp, const LAS float* qs) {
    float s = 0.f;
#pragma unroll
    for (int c = 0; c < 8; ++c) { const u32x4 x = *(const u32x4*)(kp + 8 * c); const f32x4 q0 = *(const LAS f32x4*)(qs + 8 * c), q1 = *(const LAS f32x4*)(qs + 8 * c + 4);
        s += bflo(x.x) * q0[0] + bfhi(x.x) * q0[1] + bflo(x.y) * q0[2] + bfhi(x.y) * q0[3] + bflo(x.z) * q1[0] + bfhi(x.z) * q1[1] + bflo(x.w) * q1[2] + bfhi(x.w) * q1[3]; }
    return s;
}
DI float kdot_f32(const float* kp, const LAS float* qs) {
    float s = 0.f;
#pragma unroll
    for (int c = 0; c < 16; ++c) { const f32x4 x = *(const f32x4*)(kp + 4 * c); const f32x4 q = *(const LAS f32x4*)(qs + 4 * c); s += x[0] * q[0] + x[1] * q[1] + x[2] * q[2] + x[3] * q[3]; }
    return s;
}
template <class VF> DI void att_block(float s, bool valid, int nkeys, float& m, float& l, float& o, VF vf) {
    const float bm = wave_max(valid ? s : -1e30f);
    if (bm <= -1e30f) return;
    const float mn = fmaxf(m, bm), alpha = __expf(m - mn), p = valid ? __expf(s - mn) : 0.f;
    l = l * alpha + wave_sum(p); o *= alpha; m = mn;
    for (int rr = 0; rr < nkeys; ++rr) o += __shfl(p, rr) * vf(rr);
}
template <bool SAMPLE> DI void nsa_naive(const CArgs& a, const Ctx& C, int b, int t) {
    constexpr int NC = SAMPLE ? 256 : 64, NS = SAMPLE ? 129 : 32;
    const int lane = C.lane, hd = C.wave, g = hd >> 2, row = SAMPLE ? MP + b : b * SEQ + t;
    LAS float* qs = (LAS float*)C.lds + hd * 64;
    LAS float* P = (LAS float*)C.lds + 512 + hd * 256;
    LAS float* SC = (LAS float*)C.lds + 512 + 2048;
    LAS int* SEL = (LAS int*)((LAS float*)C.lds + 512 + 2048 + 384);
    const bf16* H = (const bf16*)(a.ws + WS_H); const float* HS = (const float*)(a.ws + WS_HS);
    const bf16* Hr = H + (size_t)row * NE;
    const float* cache = (const float*)a.in[I_CACHE]; const int* pt = (const int*)a.in[I_PT] + b * NPAGE;
    qs[lane] = bf2f(Hr[CE_QB + hd * 64 + lane]) * 0.125f;
    LDS_WAIT();
    const float* kcb = SAMPLE ? (const float*)(a.ws + WS_KCBS) + (size_t)b * 256 * 256 : (const float*)(a.ws + WS_KCBP) + (size_t)b * 64 * 256;
    const int nvalid = SAMPLE ? 256 : (t + 1) / 32;
    float sc[NC / 64]; float mx = -1e30f;
#pragma unroll
    for (int j = 0; j < NC / 64; ++j) { const int c = lane + 64 * j; sc[j] = kdot_f32(kcb + (size_t)c * 256 + g * 64, qs); if (c < nvalid) mx = fmaxf(mx, sc[j]); }
    mx = wave_max(mx); float sum = 0.f;
#pragma unroll
    for (int j = 0; j < NC / 64; ++j) { const int c = lane + 64 * j; sc[j] = (c < nvalid) ? __expf(sc[j] - mx) : 0.f; sum += sc[j]; }
    sum = wave_sum(sum); const float inv = sum > 0.f ? 1.f / sum : 0.f;
#pragma unroll
    for (int j = 0; j < NC / 64; ++j) P[lane + 64 * j] = sc[j] * inv;
    LDS_WAIT();
    float o_cmp = 0.f;
    for (int c = 0; c < nvalid; ++c) o_cmp += P[c] * kcb[(size_t)c * 256 + 128 + g * 64 + lane];
    __syncthreads();
    if ((hd & 3) == 0) {
        const LAS float* Pg = (LAS float*)C.lds + 512 + g * 4 * 256; const int cur = t >> 6;
#pragma unroll
        for (int jj = 0; jj < (NS + 63) / 64; ++jj) { const int j = lane + 64 * jj;
            if (j < NS) { float imp = 0.f;
                if (2 * j + 1 < NC) { const float i0 = ((Pg[2 * j] + Pg[256 + 2 * j]) + Pg[512 + 2 * j]) + Pg[768 + 2 * j], i1 = ((Pg[2 * j + 1] + Pg[256 + 2 * j + 1]) + Pg[512 + 2 * j + 1]) + Pg[768 + 2 * j + 1]; imp = i0 + i1; }
                const bool forced = (j == 0) || (j == cur) || (j == cur - 1), valid = j * 64 <= t;
                SC[g * 192 + j] = forced ? 1e9f : (valid ? imp : -1e30f); } }
        LDS_WAIT();
#pragma unroll
        for (int jj = 0; jj < (NS + 63) / 64; ++jj) { const int j = lane + 64 * jj;
            if (j < NS) { const float sj = SC[g * 192 + j]; int rank = 0;
                for (int i = 0; i < NS; ++i) { const float si = SC[g * 192 + i]; rank += (si > sj || (si == sj && i < j)) ? 1 : 0; }
                SEL[g * 192 + j] = rank < 16 ? 1 : 0; } }
    }
    __syncthreads();
    float m_s = -1e30f, l_s = 0.f, o_s = 0.f;
    for (int j = 0; j < NS; ++j) {
        if (!SEL[g * 192 + j] || j * 64 > t) continue;
        const int kpos = j * 64 + lane; const bool valid = kpos <= t; const int nk = min(64, t - j * 64 + 1);
        if (SAMPLE) {
            if (j == 128) {
                const float s = wave_sum(qs[lane] * bf2f(Hr[CE_KV + 256 + g * 64 + lane]));
                const float vv = bf2f(Hr[CE_KV + 384 + g * 64 + lane]);
                const float mn = fmaxf(m_s, s), alpha = __expf(m_s - mn), p = __expf(s - mn); l_s = l_s * alpha + p; o_s = o_s * alpha + p * vv; m_s = mn;
            } else {
                const float* pg = cache + ((size_t)pt[j >> 1] * 128 + (j & 1) * 64) * 512;
                const float s = kdot_f32(pg + (size_t)lane * 512 + 256 + g * 64, qs);
                att_block(s, true, 64, m_s, l_s, o_s, [&](int rr) { return pg[(size_t)rr * 512 + 384 + g * 64 + lane]; });
            }
        } else {
            const bf16* kb = H + (size_t)(b * SEQ + j * 64) * NE + CE_KV + 256 + g * 64;
            const float s = valid ? kdot_bf16(kb + (size_t)lane * NE, qs) : 0.f;
            att_block(s, valid, nk, m_s, l_s, o_s, [&](int rr) { return bf2f(kb[(size_t)rr * NE + 128 + lane]); });
        }
    }
    float m_w = -1e30f, l_w = 0.f, o_w = 0.f;
    if (SAMPLE) {
        const float* wb = (const float*)a.in[I_WINST] + (size_t)b * 512 * 256;
        for (int c = 0; c < 8; ++c) { const int i = c * 64 + lane; const bool valid = i >= 1;
            const float s = kdot_f32(wb + (size_t)i * 256 + g * 64, qs);
            att_block(s, valid, 64, m_w, l_w, o_w, [&](int rr) { return wb[(size_t)(c * 64 + rr) * 256 + 128 + g * 64 + lane]; }); }
        { const float s = wave_sum(qs[lane] * bf2f(Hr[CE_KV + 512 + g * 64 + lane])); const float vv = bf2f(Hr[CE_KV + 640 + g * 64 + lane]);
          const float mn = fmaxf(m_w, s), alpha = __expf(m_w - mn), p = __expf(s - mn); l_w = l_w * alpha + p; o_w = o_w * alpha + p * vv; m_w = mn; }
    } else {
        const int k0 = max(0, t - 511);
        for (int kb0 = k0; kb0 <= t; kb0 += 64) { const int kpos = kb0 + lane; const bool valid = kpos <= t; const int nk = min(64, t - kb0 + 1);
            const bf16* kb = H + (size_t)(b * SEQ + kb0) * NE + CE_KV + 512 + g * 64;
            const float s = valid ? kdot_bf16(kb + (size_t)lane * NE, qs) : 0.f;
            att_block(s, valid, nk, m_w, l_w, o_w, [&](int rr) { return bf2f(kb[(size_t)rr * NE + 128 + lane]); }); }
    }
    const float* gp = HS + (size_t)row * 32 + 8 + hd * 3;
    const float o = sigmoidf_(gp[0]) * o_cmp + sigmoidf_(gp[1]) * (l_s > 0.f ? o_s / l_s : 0.f) + sigmoidf_(gp[2]) * (l_w > 0.f ? o_w / l_w : 0.f);
    ((bf16*)(a.ws + WS_MIX))[(size_t)row * DM + 512 + hd * 64 + lane] = (bf16)f2bf(o);
    __syncthreads();
}
#ifndef NSA_NAIVE
#define NSA_NAIVE 0
#endif
DI void mix_even(const CArgs& a, const Ctx& C) {
    if (C.bid < 32) delta_scan(a, C, C.bid);
    else if (C.bid < 64) {
        const int u = C.bid - 32;
        nsa_naive<true>(a, C, u, PAST);
        const float* wb = (const float*)a.in[I_WINST] + (size_t)u * 512 * 256; float* wo = a.out + O_WIN_S + (size_t)u * 512 * 256;
        for (int x = C.tid; x < 511 * 64; x += NTHREADS) *(f32x4*)(wo + (size_t)x * 4) = *(const f32x4*)(wb + 256 + (size_t)x * 4);
    } else if (C.bid < 192) delta_sample(a, C, C.bid - 64);
#if NSA_NAIVE
    for (int u = C.bid; u < MP; u += C.G) nsa_naive<false>(a, C, u >> 11, u & (SEQ - 1));
#else
    LAS unsigned* slot = (LAS unsigned*)(C.lds + LDS_BYTES - 16);
    unsigned* head = (unsigned*)(a.ws + WS_CTL) + CTL_QUEUE;
    for (;;) {
        __syncthreads();
        if (C.tid == 0) *slot = __hip_atomic_fetch_add(head, 1u, __ATOMIC_RELAXED, __HIP_MEMORY_SCOPE_AGENT);
        __syncthreads();
        const unsigned u = *slot;
        if (u >= 512u) break;
        nsa_unit(a, C, (int)((u & 15u) >> 1), (int)(u & 1u), 31 - (int)(u >> 4));
    }
#endif
}
DI void gla_chunk_prep(const CArgs& a, const Ctx& C, int unit) {
    const int b = unit >> 7, h = (unit >> 5) & 3, n = unit & 31, tid = C.tid, lane = C.lane, wave = C.wave, row0 = b * SEQ + n * 64;
    const bf16* H = (const bf16*)(a.ws + WS_H); const float* HS = (const float*)(a.ws + WS_HS);
    unsigned char* ck = a.ws + WS_CHK + (size_t)unit * CHK_BYTES;
    LAS bf16* QTs = (LAS bf16*)(C.lds); LAS bf16* KTs = (LAS bf16*)(C.lds + 17408); LAS bf16* KDs = (LAS bf16*)(C.lds + 34816);
    LAS float* G1 = (LAS float*)(C.lds + 53248);
    LAS float* PS = (LAS float*)(C.lds + 57344);
    for (int x = tid; x < 1024; x += NTHREADS) G1[x] = HS[(size_t)(row0 + (x >> 4)) * 32 + (x & 15)];
    const int d = tid & 127, part = tid >> 7;
    float w2[16]; const float* W2 = (const float*)a.in[I_WG2] + h * 128 + d;
#pragma unroll
    for (int j = 0; j < 16; ++j) w2[j] = W2[j * 512];
    const float b2 = ((const float*)a.in[I_BG2])[h * 128 + d];
    __syncthreads();
    float la[16], run = 0.f;
#pragma unroll
    for (int ii = 0; ii < 16; ++ii) { const int i = part * 16 + ii; float x = b2;
#pragma unroll
        for (int j = 0; j < 16; ++j) x += G1[i * 16 + j] * w2[j];
        run += logsigmoidf_(x) * (1.f / 16.f); la[ii] = run; }
    PS[part * 128 + d] = run;
    __syncthreads();
    float off = 0.f, tot = 0.f;
#pragma unroll
    for (int pp = 0; pp < 4; ++pp) { const float v = PS[pp * 128 + d]; if (pp < part) off += v; tot += v; }
#pragma unroll
    for (int ii = 0; ii < 16; ++ii) { const int i = part * 16 + ii; const float bc = la[ii] + off; const bf16* hr = H + (size_t)(row0 + i) * NO + h * 128 + d;
        const float q = bf2f(hr[CO_Q]) * 0.08838834764831845f, k = bf2f(hr[CO_K]);
        const bf16 qt = (bf16)f2bf(q * __expf(bc));
        QTs[i * LDA + d] = qt; *(bf16*)(ck + GK_QT + (i * 128 + d) * 2) = qt;
        KTs[i * LDA + d] = (bf16)f2bf(k * __expf(-bc));
        KDs[d * LDT + i] = (bf16)f2bf(k * __expf(tot - bc)); }
    if (part == 0) *(float*)(ck + GK_GL + d * 4) = __expf(tot);
    __syncthreads();
    for (int x = tid; x < 128 * 8; x += NTHREADS) { const int dd = x >> 3, c8 = x & 7; *(u32x4*)(ck + GK_KDT + (dd * 64 + c8 * 8) * 2) = *(const LAS u32x4*)(KDs + dd * LDT + c8 * 8); }
    if (wave < 4) { const int ti = wave >> 1, tj = wave & 1, r = lane & 31, hh = lane >> 5; f32x16 acc = {};
        acc = mm_tile<128>(QTs + ti * 32 * LDA, LDA, KTs + tj * 32 * LDA, LDA, acc, lane);
        const int j = tj * 32 + r;
#pragma unroll
        for (int reg = 0; reg < 16; ++reg) { const int i = ti * 32 + crow(reg, hh); *(bf16*)(ck + GK_ATT + (i * 64 + j) * 2) = (bf16)f2bf(i >= j ? acc[reg] : 0.f); } }
    __syncthreads();
}
DI void prep_odd(const CArgs& a, const Ctx& C) { for (int u = C.bid; u < 1024; u += C.G) gla_chunk_prep(a, C, u); }

DI void gla_scan(const CArgs& a, const Ctx& C, int unit) {
    const int bh = unit >> 2, es = unit & 3, b = bh >> 2, h = bh & 3, tid = C.tid, lane = C.lane, wave = C.wave, r = lane & 31, hh = lane >> 5, dt = wave >> 1, et = wave & 1;
    LAS bf16* STs = (LAS bf16*)(C.lds); LAS bf16* QTs = (LAS bf16*)(C.lds + 17408); LAS bf16* ATs = (LAS bf16*)(C.lds + 34816); LAS bf16* VT = (LAS bf16*)(C.lds + 44032); LAS bf16* KDs = (LAS bf16*)(C.lds + 53248);
    LAS float* GL = (LAS float*)(C.lds + 71680);
    const bf16* H = (const bf16*)(a.ws + WS_H); float* OG = (float*)(a.ws + WS_Y);
    f32x16 S = {};
    for (int x = tid; x < 64 * LDA / 2; x += NTHREADS) ((LAS unsigned*)STs)[x] = 0u;
    for (int n = 0; n < 32; ++n) {
        const unsigned char* ck = a.ws + WS_CHK + (size_t)(bh * 32 + n) * CHK_BYTES; const int row0 = b * SEQ + n * 64;
        for (int x = tid; x < 1024; x += NTHREADS) { const int rw = x >> 4, c8 = x & 15; *(LAS u32x4*)(QTs + rw * LDA + c8 * 8) = *(const u32x4*)(ck + GK_QT + x * 16); }
        for (int x = tid; x < 1024; x += NTHREADS) { const int rw = x >> 3, c8 = x & 7; *(LAS u32x4*)(KDs + rw * LDT + c8 * 8) = *(const u32x4*)(ck + GK_KDT + x * 16); }
        { const int x = tid, rw = x >> 3, c8 = x & 7; *(LAS u32x4*)(ATs + rw * LDT + c8 * 8) = *(const u32x4*)(ck + GK_ATT + x * 16); }
        { const int s = tid >> 3, c8 = tid & 7; const u32x4 x = *(const u32x4*)(H + (size_t)(row0 + s) * NO + CO_V + h * 256 + es * 64 + c8 * 8); const unsigned w[4] = {x.x, x.y, x.z, x.w};
#pragma unroll
          for (int k = 0; k < 4; ++k) { VT[(c8 * 8 + 2 * k) * LDT + s] = (bf16)(w[k] & 0xffffu); VT[(c8 * 8 + 2 * k + 1) * LDT + s] = (bf16)(w[k] >> 16); } }
        if (tid < 128) GL[tid] = *(const float*)(ck + GK_GL + tid * 4);
        __syncthreads();
        if (wave < 4) {
            f32x16 o = {};
            o = mm_tile<128>(QTs + 32 * dt * LDA, LDA, STs + 32 * et * LDA, LDA, o, lane);
            o = mm_tile<64>(ATs + 32 * dt * LDT, LDT, VT + 32 * et * LDT, LDT, o, lane);
#pragma unroll
            for (int reg = 0; reg < 16; ++reg) OG[(size_t)(row0 + 32 * dt + crow(reg, hh)) * DM + h * 256 + es * 64 + 32 * et + r] = o[reg];
        }
        __syncthreads();
#pragma unroll
        for (int reg = 0; reg < 16; ++reg) S[reg] *= GL[32 * dt + crow(reg, hh)];
        S = mm_tile<64>(KDs + 32 * dt * LDT, LDT, VT + 32 * et * LDT, LDT, S, lane);
#pragma unroll
        for (int g4 = 0; g4 < 4; ++g4) { u32x2 pk; pk.x = pk2(S[4 * g4], S[4 * g4 + 1]); pk.y = pk2(S[4 * g4 + 2], S[4 * g4 + 3]);
            *(LAS u32x2*)(STs + (32 * et + r) * LDA + 32 * dt + 8 * g4 + 4 * hh) = pk; }
        __syncthreads();
    }
    float* So = a.out + O_GS_P + (size_t)bh * 128 * 256;
#pragma unroll
    for (int reg = 0; reg < 16; ++reg) So[(size_t)(32 * dt + crow(reg, hh)) * 256 + es * 64 + 32 * et + r] = S[reg];
}
DI void gla_sample(const CArgs& a, const Ctx& C, int unit) {
    const int b = unit >> 2, h = unit & 3, tid = C.tid, lane = C.lane, wave = C.wave, row = MP + b;
    LAS float* qa = (LAS float*)C.lds;
    LAS float* kk = qa + 128; LAS float* aa = qa + 256; LAS float* vv = qa + 384; LAS float* oo = qa + 640; LAS float* part = qa + 896; LAS float* scal = qa + 1408;
    const bf16* Hr = (const bf16*)(a.ws + WS_H) + (size_t)row * NO; const float* g1 = (const float*)(a.ws + WS_HS) + (size_t)row * 32;
    if (tid < 128) { const int d = tid; float x = ((const float*)a.in[I_BG2])[h * 128 + d]; const float* W2 = (const float*)a.in[I_WG2] + h * 128 + d;
#pragma unroll
        for (int j = 0; j < 16; ++j) x += g1[j] * W2[j * 512];
        const float av = __expf(logsigmoidf_(x) * (1.f / 16.f)); const float q = bf2f(Hr[CO_Q + h * 128 + d]) * 0.08838834764831845f, k = bf2f(Hr[CO_K + h * 128 + d]);
        qa[d] = q * av; kk[d] = k; aa[d] = av; part[d] = q * k; }
    else if (tid < 384) vv[tid - 128] = bf2f(Hr[CO_V + h * 256 + tid - 128]);
    __syncthreads();
    if (wave == 0) { const float s = wave_sum(part[lane] + part[64 + lane]); if (lane == 0) scal[0] = s; }
    __syncthreads();
    const float qk = scal[0]; const float* S0 = (const float*)a.in[I_GS] + (size_t)unit * 128 * 256; float* So = a.out + O_GS_S + (size_t)unit * 128 * 256;
    const int e = tid & 255, pt = tid >> 8; float acc = 0.f; const float ve = vv[e];
#pragma unroll 8
    for (int d = pt * 64; d < pt * 64 + 64; ++d) { const float s = S0[d * 256 + e]; acc += qa[d] * s; So[d * 256 + e] = aa[d] * s + kk[d] * ve; }
    __syncthreads();
    part[pt * 256 + e] = acc;
    __syncthreads();
    if (tid < 256) oo[e] = part[e] + part[256 + e] + qk * ve;
    __syncthreads();
    if (wave == 0) { float ss = 0.f;
#pragma unroll
        for (int k = 0; k < 4; ++k) ss += oo[lane + 64 * k] * oo[lane + 64 * k];
        const float rs = rsqrtf(wave_sum(ss) * (1.f / 256.f) + 1e-6f); const float* gng = (const float*)a.in[I_GNG]; bf16* op = (bf16*)(a.ws + WS_MIX) + (size_t)row * DM + h * 256;
#pragma unroll
        for (int k = 0; k < 4; ++k) { const int ee = lane + 64 * k; op[ee] = (bf16)f2bf(oo[ee] * rs * gng[ee] * siluf_(bf2f(Hr[CO_R + h * 256 + ee]))); } }
    __syncthreads();
}
DI void mix_odd(const CArgs& a, const Ctx& C) {
    for (int u = C.bid; u < 128; u += C.G) gla_scan(a, C, u);
    for (int u = C.G - 1 - C.bid; u < 128; u += C.G) gla_sample(a, C, u);
}
DI void gla_norm(const CArgs& a, const Ctx& C) {
    const int gw = C.bid * NWAVES + C.wave, NGW = C.G * NWAVES, lane = C.lane;
    const float* OG = (const float*)(a.ws + WS_Y); const bf16* H = (const bf16*)(a.ws + WS_H); bf16* MIX = (bf16*)(a.ws + WS_MIX); const float* gng = (const float*)a.in[I_GNG];
    const f32x4 gv = *(const f32x4*)(gng + 4 * lane);
    for (int it = gw; it < MP * 4; it += NGW) { const int row = it >> 2, h = it & 3;
        const f32x4 o = *(const f32x4*)(OG + (size_t)row * DM + h * 256 + 4 * lane);
        const float rs = rsqrtf(wave_sum(o[0] * o[0] + o[1] * o[1] + o[2] * o[2] + o[3] * o[3]) * (1.f / 256.f) + 1e-6f);
        const u32x2 rr = *(const u32x2*)(H + (size_t)row * NO + CO_R + h * 256 + 4 * lane);
        u32x2 w; w.x = pk2(o[0] * rs * gv[0] * siluf_(bflo(rr.x)), o[1] * rs * gv[1] * siluf_(bfhi(rr.x))); w.y = pk2(o[2] * rs * gv[2] * siluf_(bflo(rr.y)), o[3] * rs * gv[3] * siluf_(bfhi(rr.y)));
        *(u32x2*)(MIX + (size_t)row * DM + h * 256 + 4 * lane) = w; }
}
template <class Epi> DI void run_gemm(const Ctx& C, const bf16* A, const bf16* Bt, int N, int K, const Epi& E) {
    pg8::Gemm g{A, Bt, MT, N, K}; pg8::StaticOrder S; S.init(MT, N, C.G, C.bid);
    pg8::gemm_phase<Epi, pg8::StaticOrder, true, true>(C.lds, g, S, E);
}
constexpr int NPH = 18;
DI const CArgs& kargs() { auto p = __builtin_amdgcn_kernarg_segment_ptr(); asm volatile("" : "+s"(p)); return *(const CArgs*)p; }
__global__ void __launch_bounds__(NTHREADS, 2) mk(Args a_unused) {
    extern __shared__ __attribute__((aligned(16))) unsigned char lds_raw[];
    Ctx C; C.lds = (LAS unsigned char*)lds_raw; C.tid = threadIdx.x; C.lane = C.tid & 63; C.wave = __builtin_amdgcn_readfirstlane(C.tid >> 6); C.G = gridDim.x; C.bid = blockIdx.x;
    cg::grid_group grid = cg::this_grid();
#define PH(k) if (const CArgs& a = kargs(); a.ph_lo <= (k) && (k) < a.ph_hi)
#define SEAM(k) do { const CArgs& a = kargs(); if (a.ph_lo <= (k) && (k) + 1 < a.ph_hi) { __syncthreads(); grid.sync(); } } while (0)
#define WSP(T, off) ((T*)(a.ws + (off)))
    PH(0) p0_prologue(a, C);
    SEAM(0);
    PH(1) { pg8::EpiInE E{WSP(bf16, WS_H), WSP(float, WS_HS), a.out}; run_gemm(C, WSP(const bf16, WS_XB), WSP(const bf16, WS_WINE), NE, DM, E); }
    SEAM(1);
    PH(2) prep_even(a, C);
    SEAM(2);
    PH(3) mix_even(a, C);
    SEAM(3);
    PH(4) { pg8::EpiF32 E{WSP(float, WS_Y)}; run_gemm(C, WSP(const bf16, WS_MIX), WSP(const bf16, WS_WOE), DM, DM, E); }
    SEAM(4);
    PH(5) ln_phase(a, C, 0, 0);
    SEAM(5);
    PH(6) { pg8::EpiGU E{WSP(bf16, WS_FF)}; run_gemm(C, WSP(const bf16, WS_XB), WSP(const bf16, WS_WGU), NGU, DM, E); }
    SEAM(6);
    PH(7) { pg8::EpiF32 E{WSP(float, WS_Y)}; run_gemm(C, WSP(const bf16, WS_FF), WSP(const bf16, WS_WD), DM, DFF, E); }
    SEAM(7);
    PH(8) ln_phase(a, C, 0, 1);
    SEAM(8);
    PH(9) { pg8::EpiInO E{WSP(bf16, WS_H), WSP(float, WS_HS)}; run_gemm(C, WSP(const bf16, WS_XB), WSP(const bf16, WS_WINO), NO, DM, E); }
    SEAM(9);
    PH(10) prep_odd(a, C);
    SEAM(10);
    PH(11) mix_odd(a, C);
    SEAM(11);
    PH(12) gla_norm(a, C);
    SEAM(12);
    PH(13) { pg8::EpiF32 E{WSP(float, WS_Y)}; run_gemm(C, WSP(const bf16, WS_MIX), WSP(const bf16, WS_WOO), DM, DM, E); }
    SEAM(13);
    PH(14) ln_phase(a, C, 1, 0);
    SEAM(14);
    PH(15) { pg8::EpiGU E{WSP(bf16, WS_FF)}; run_gemm(C, WSP(const bf16, WS_XB), WSP(const bf16, WS_WGU + al((size_t)NGU * DM * 2)), NGU, DM, E); }
    SEAM(15);
    PH(16) { pg8::EpiF32 E{WSP(float, WS_Y)}; run_gemm(C, WSP(const bf16, WS_FF), WSP(const bf16, WS_WD + al((size_t)DM * DFF * 2)), DM, DFF, E); }
    SEAM(16);
    PH(17) ln_phase(a, C, 1, 1);
}

#ifndef MK_N_LAUNCHES
#define MK_N_LAUNCHES 1
#endif
extern "C" void kernel_launch(void* const* d_in, const int* in_sizes, int n_in, void* d_out, int out_size, void* d_ws, size_t ws_size, hipStream_t stream) {
    static int grid = 0;
    if (grid == 0) {
        if (n_in != N_IN || out_size != (int)O_END || ws_size < WS_END) { fprintf(stderr, "kernel_launch: unexpected shapes n_in %d out %d ws %zu (need %zu)\n", n_in, out_size, ws_size, (size_t)WS_END); grid = -1; return; }
        int dev = 0, cus = 0, per_cu = 0;
        hipGetDevice(&dev); hipDeviceGetAttribute(&cus, hipDeviceAttributeMultiprocessorCount, dev);
        if (hipFuncSetAttribute((const void*)mk, hipFuncAttributeMaxDynamicSharedMemorySize, LDS_BYTES) != hipSuccess) { fprintf(stderr, "kernel_launch: hipFuncSetAttribute failed\n"); grid = -1; return; }
        hipOccupancyMaxActiveBlocksPerMultiprocessor(&per_cu, (const void*)mk, NTHREADS, LDS_BYTES);
        (void)hipGetLastError();
        if (per_cu < 1) { fprintf(stderr, "kernel_launch: occupancy query says %d blocks/CU\n", per_cu); grid = -1; return; }
        grid = cus;
    }
    if (grid < 0) return;
    Args a{};
    for (int i = 0; i < N_IN; ++i) a.in[i] = d_in[i];
    a.out = (float*)d_out; a.ws = (unsigned char*)d_ws;
    if (MK_N_LAUNCHES == 1) {
        a.ph_lo = 0; a.ph_hi = NPH; void* args[] = {&a};
        hipError_t e = hipLaunchCooperativeKernel((const void*)mk, dim3(grid), dim3(NTHREADS), args, LDS_BYTES, stream);
        if (e != hipSuccess) fprintf(stderr, "cooperative launch failed: %s (grid %d)\n", hipGetErrorString(e), grid);
    } else {
        for (int p = 0; p < NPH; ++p) { a.ph_lo = p; a.ph_hi = p + 1; void* args[] = {&a};
            hipError_t e = hipLaunchCooperativeKernel((const void*)mk, dim3(grid), dim3(NTHREADS), args, LDS_BYTES, stream);
            if (e != hipSuccess) { fprintf(stderr, "launch %d failed: %s\n", p, hipGetErrorString(e)); break; } }
    }
}
```
